# Optimizing an MI355X kernel written in HIP

```python
import jax, jax.numpy as jnp
from jax import lax
import numpy as np

D_MODEL = 1024
BATCH = 32
SEQ = 2048
DEPTH = 1

D_MIX = D_MODEL
D_A = D_MIX // 2
D_B = D_MIX - D_A
N_HEADS_A = 4
HEAD_DIM_A = D_A // N_HEADS_A
CHUNK = 128
N_GROUPS_B = 4
GROUP_DIM_B = D_B // N_GROUPS_B
D_IN = 3 * D_A + 2 * D_B
EPS = 1e-6

kernel_name = "hybrid_gmlp_fnet_encoder_layer"


def rms_norm(x, g):
    xf = x.astype(jnp.float32)
    ms = jnp.mean(xf * xf, axis=-1, keepdims=True)
    return (xf * lax.rsqrt(ms + EPS)).astype(x.dtype) * g


def layer_norm(x, g, b):
    xf = x.astype(jnp.float32)
    mu = jnp.mean(xf, axis=-1, keepdims=True)
    var = jnp.mean(jnp.square(xf - mu), axis=-1, keepdims=True)
    return ((xf - mu) * lax.rsqrt(var + EPS)).astype(x.dtype) * g + b


def spatial_gating(u, v, w_s, b_s, ln_g, ln_b):
    bsz, s, _ = u.shape
    v = layer_norm(v, ln_g, ln_b)
    vc = v.reshape(bsz, s // CHUNK, CHUNK, N_HEADS_A, HEAD_DIM_A)
    mixed = jnp.einsum('hpq,bcqhd->bcphd', w_s, vc) + b_s.T[None, None, :, :, None]
    return u * mixed.reshape(bsz, s, D_A)


def fourier_mix(z, w_f, b_f):
    bsz, s, _ = z.shape
    zg = z.reshape(bsz, s, N_GROUPS_B, GROUP_DIM_B).astype(jnp.float32)
    f = jnp.fft.fftn(zg, axes=(1, 3), norm="ortho").real.astype(z.dtype)
    y = jnp.einsum('bsgc,gce->bsge', f, w_f) + b_f
    return y.reshape(bsz, s, D_B)


def setup_inputs(seed: int = 0) -> dict:
    key = jax.random.key(seed)
    ks = jax.random.split(key, 16)
    f32 = jnp.float32
    x = jax.random.normal(ks[0], (BATCH, SEQ, D_MODEL), f32)
    pre_g = 1.0 + 0.02 * jax.random.normal(ks[1], (DEPTH, D_MODEL), f32)
    post_g = 1.0 + 0.02 * jax.random.normal(ks[2], (DEPTH, D_MODEL), f32)
    w_in = jax.random.normal(ks[3], (DEPTH, D_MODEL, D_IN), f32) * D_MODEL ** -0.5
    ln_g = 1.0 + 0.02 * jax.random.normal(ks[4], (DEPTH, D_A), f32)
    ln_b = 0.02 * jax.random.normal(ks[5], (DEPTH, D_A), f32)
    w_s = jax.random.normal(ks[6], (DEPTH, N_HEADS_A, CHUNK, CHUNK), f32) * CHUNK ** -0.5
    b_s = 0.02 * jax.random.normal(ks[7], (DEPTH, N_HEADS_A, CHUNK), f32)
    w_f = jax.random.normal(ks[8], (DEPTH, N_GROUPS_B, GROUP_DIM_B, GROUP_DIM_B), f32) * GROUP_DIM_B ** -0.5
    b_f = 0.02 * jax.random.normal(ks[9], (DEPTH, N_GROUPS_B, GROUP_DIM_B), f32)
    w_out = jax.random.normal(ks[10], (DEPTH, D_MIX, D_MODEL), f32) * D_MIX ** -0.5
    return {"x": x, "pre_g": pre_g, "post_g": post_g, "w_in": w_in,
            "ln_g": ln_g, "ln_b": ln_b, "w_s": w_s, "b_s": b_s,
            "w_f": w_f, "b_f": b_f, "w_out": w_out}


def reference(x, pre_g, post_g, w_in, ln_g, ln_b, w_s, b_s, w_f, b_f, w_out):
    for l in range(DEPTH):
        h = rms_norm(x, pre_g[l])
        p = jnp.einsum('bsd,de->bse', h, w_in[l])
        u_a, v_a, g_a, z_b, g_b = jnp.split(
            p, [D_A, 2 * D_A, 3 * D_A, 3 * D_A + D_B], axis=-1)
        a = spatial_gating(jax.nn.gelu(u_a, approximate=False),
                           jax.nn.gelu(v_a, approximate=False),
                           w_s[l], b_s[l], ln_g[l], ln_b[l]) * jax.nn.silu(g_a)
        b = fourier_mix(z_b, w_f[l], b_f[l]) * jax.nn.silu(g_b)
        y = jnp.einsum('bse,ed->bsd', jnp.concatenate([a, b], axis=-1), w_out[l])
        x = x + rms_norm(y, post_g[l])
    return x
```

```cpp
#include <hip/hip_runtime.h>
#include <cstdio>
#include <cstdint>
#include <cstring>

namespace {
constexpr int D = 1024, BATCH = 32, SEQ = 2048, DA = 512, DB = 512, NH = 4, HD = 128, CH = 128, NG = 4, GD = 128, DIN = 2560;
constexpr float EPS = 1e-6f;
constexpr int GB = 8;
constexpr int MG = GB * SEQ;

__device__ __forceinline__ float gelu_f(float v) { return 0.5f * v * (1.0f + erff(v * 0.70710678118654752f)); }
__device__ __forceinline__ float silu_f(float v) { return v / (1.0f + __expf(-v)); }
__device__ __forceinline__ float wave_sum(float v) {
#pragma unroll
    for (int o = 1; o < 64; o <<= 1) v += __shfl_xor(v, o);
    return v;
}

__global__ void __launch_bounds__(256) k_rmsnorm(const float* __restrict__ x, const float* __restrict__ g, float* __restrict__ h, int rows) {
    const int row = blockIdx.x * 4 + (threadIdx.x >> 6), lane = threadIdx.x & 63;
    if (row >= rows) return;
    const float4* xr = (const float4*)(x + (size_t)row * D);
    float4 v[4]; float s = 0.f;
#pragma unroll
    for (int j = 0; j < 4; ++j) { v[j] = xr[lane + 64 * j]; s += v[j].x * v[j].x + v[j].y * v[j].y + v[j].z * v[j].z + v[j].w * v[j].w; }
    const float r = rsqrtf(wave_sum(s) * (1.0f / D) + EPS);
    float4* hr = (float4*)(h + (size_t)row * D);
#pragma unroll
    for (int j = 0; j < 4; ++j) { const float4 gg = ((const float4*)g)[lane + 64 * j]; hr[lane + 64 * j] = make_float4(v[j].x * r * gg.x, v[j].y * r * gg.y, v[j].z * r * gg.z, v[j].w * r * gg.w); }
}

__global__ void __launch_bounds__(256) k_final(const float* __restrict__ x, const float* __restrict__ y, const float* __restrict__ g, float* __restrict__ out, int rows) {
    const int row = blockIdx.x * 4 + (threadIdx.x >> 6), lane = threadIdx.x & 63;
    if (row >= rows) return;
    const float4* yr = (const float4*)(y + (size_t)row * D); const float4* xr = (const float4*)(x + (size_t)row * D);
    float4 v[4]; float s = 0.f;
#pragma unroll
    for (int j = 0; j < 4; ++j) { v[j] = yr[lane + 64 * j]; s += v[j].x * v[j].x + v[j].y * v[j].y + v[j].z * v[j].z + v[j].w * v[j].w; }
    const float r = rsqrtf(wave_sum(s) * (1.0f / D) + EPS);
    float4* orow = (float4*)(out + (size_t)row * D);
#pragma unroll
    for (int j = 0; j < 4; ++j) { const float4 gg = ((const float4*)g)[lane + 64 * j]; const float4 xx = xr[lane + 64 * j];
        orow[lane + 64 * j] = make_float4(xx.x + v[j].x * r * gg.x, xx.y + v[j].y * r * gg.y, xx.z + v[j].z * r * gg.z, xx.w + v[j].w * r * gg.w); }
}

struct GemmP { const float* A; const float* B; float* C; int M, N, K, lda, ldb, ldc, nz0, pad; long sA0, sA1, sB0, sB1, sC0, sC1; };
__global__ void __launch_bounds__(256) k_gemm(GemmP p) {
    __shared__ float As[16][65]; __shared__ float Bs[16][65];
    const int z = blockIdx.z, z0 = z % p.nz0, z1 = z / p.nz0;
    const float* A = p.A + z0 * p.sA0 + z1 * p.sA1; const float* B = p.B + z0 * p.sB0 + z1 * p.sB1; float* C = p.C + z0 * p.sC0 + z1 * p.sC1;
    const int m0 = blockIdx.y * 64, n0 = blockIdx.x * 64, tid = threadIdx.x, tx = tid & 15, ty = tid >> 4;
    float acc[4][4];
#pragma unroll
    for (int i = 0; i < 4; ++i)
#pragma unroll
        for (int j = 0; j < 4; ++j) acc[i][j] = 0.f;
    for (int k0 = 0; k0 < p.K; k0 += 16) {
        { const int r = tid >> 2, c = (tid & 3) * 4; const float4 a = *(const float4*)(A + (size_t)(m0 + r) * p.lda + k0 + c); As[c + 0][r] = a.x; As[c + 1][r] = a.y; As[c + 2][r] = a.z; As[c + 3][r] = a.w; }
        { const int r = tid >> 4, c = (tid & 15) * 4; const float4 b = *(const float4*)(B + (size_t)(k0 + r) * p.ldb + n0 + c); Bs[r][c + 0] = b.x; Bs[r][c + 1] = b.y; Bs[r][c + 2] = b.z; Bs[r][c + 3] = b.w; }
        __syncthreads();
#pragma unroll
        for (int k = 0; k < 16; ++k) {
            float a[4], b[4];
#pragma unroll
            for (int i = 0; i < 4; ++i) { a[i] = As[k][ty * 4 + i]; b[i] = Bs[k][tx * 4 + i]; }
#pragma unroll
            for (int i = 0; i < 4; ++i)
#pragma unroll
                for (int j = 0; j < 4; ++j) acc[i][j] += a[i] * b[j];
        }
        __syncthreads();
    }
#pragma unroll
    for (int i = 0; i < 4; ++i) *(float4*)(C + (size_t)(m0 + ty * 4 + i) * p.ldc + n0 + tx * 4) = make_float4(acc[i][0], acc[i][1], acc[i][2], acc[i][3]);
}

__global__ void __launch_bounds__(256) k_vln(const float* __restrict__ p, const float* __restrict__ ln_g, const float* __restrict__ ln_b, float* __restrict__ vln, int rows) {
    const int row = blockIdx.x * 4 + (threadIdx.x >> 6), lane = threadIdx.x & 63;
    if (row >= rows) return;
    const float* vr = p + (size_t)row * DIN + DA;
    float v[8]; float s = 0.f;
#pragma unroll
    for (int j = 0; j < 8; ++j) { v[j] = gelu_f(vr[lane + 64 * j]); s += v[j]; }
    const float mu = wave_sum(s) * (1.0f / DA); float q = 0.f;
#pragma unroll
    for (int j = 0; j < 8; ++j) { const float d = v[j] - mu; q += d * d; }
    const float r = rsqrtf(wave_sum(q) * (1.0f / DA) + EPS);
#pragma unroll
    for (int j = 0; j < 8; ++j) vln[(size_t)row * DA + lane + 64 * j] = (v[j] - mu) * r * ln_g[lane + 64 * j] + ln_b[lane + 64 * j];
}

__global__ void __launch_bounds__(256) k_agate(const float* __restrict__ p, const float* __restrict__ mixed, const float* __restrict__ b_s, float* __restrict__ a2, int rows) {
    const size_t i = (size_t)blockIdx.x * 256 + threadIdx.x; if (i >= (size_t)rows * DA) return;
    const int m = (int)(i / DA), j = (int)(i % DA), h = j / HD, pos = m % CH;
    const float u = p[(size_t)m * DIN + j], g = p[(size_t)m * DIN + 2 * DA + j];
    a2[(size_t)m * D + j] = gelu_f(u) * (mixed[i] + b_s[h * CH + pos]) * silu_f(g);
}
__global__ void __launch_bounds__(256) k_bgate(const float* __restrict__ p, const float* __restrict__ bf, const float* __restrict__ b_f, float* __restrict__ a2, int rows) {
    const size_t i = (size_t)blockIdx.x * 256 + threadIdx.x; if (i >= (size_t)rows * DB) return;
    const int m = (int)(i / DB), j = (int)(i % DB);
    const float g = p[(size_t)m * DIN + 3 * DA + DB + j];
    a2[(size_t)m * D + DA + j] = (bf[i] + b_f[j]) * silu_f(g);
}
__global__ void k_chanmat(float* cc, float* sc) {
    const int i = blockIdx.x * 256 + threadIdx.x; if (i >= GD * GD) return;
    const int c = i / GD, m = i % GD; const int ph = (c * m) % GD; float s, co; sincospif(2.0f * ph / (float)GD, &s, &co); cc[i] = co; sc[i] = s;
}
__global__ void k_seqmat(float* cs) {
    const size_t i = (size_t)blockIdx.x * 256 + threadIdx.x; if (i >= (size_t)SEQ * SEQ) return;
    const int k = (int)(i / SEQ), s = (int)(i % SEQ); const int ph = (k * s) % SEQ; float sn, co; sincospif(2.0f * ph / (float)SEQ, &sn, &co);
    cs[(size_t)k * (2 * SEQ) + s] = co * (1.0f / 512.0f); cs[(size_t)k * (2 * SEQ) + SEQ + s] = -sn * (1.0f / 512.0f);
}

void gemm(hipStream_t st, const float* A, const float* B, float* C, int M, int N, int K, int lda, int ldb, int ldc,
          int nz0 = 1, int nz1 = 1, long sA0 = 0, long sA1 = 0, long sB0 = 0, long sB1 = 0, long sC0 = 0, long sC1 = 0) {
    GemmP p; memset(&p, 0, sizeof(p)); p.A = A; p.B = B; p.C = C; p.M = M; p.N = N; p.K = K; p.lda = lda; p.ldb = ldb; p.ldc = ldc; p.nz0 = nz0; p.sA0 = sA0; p.sA1 = sA1; p.sB0 = sB0; p.sB1 = sB1; p.sC0 = sC0; p.sC1 = sC1;
    hipLaunchKernelGGL(k_gemm, dim3(N / 64, M / 64, nz0 * nz1), dim3(256), 0, st, p);
}
}

extern "C" void kernel_launch(void* const* d_in, const int* in_sizes, int n_in, void* d_out, int out_size, void* d_ws, size_t ws_size, hipStream_t stream) {
    const float* x = (const float*)d_in[0]; const float* pre_g = (const float*)d_in[1]; const float* post_g = (const float*)d_in[2]; const float* w_in = (const float*)d_in[3];
    const float* ln_g = (const float*)d_in[4]; const float* ln_b = (const float*)d_in[5]; const float* w_s = (const float*)d_in[6]; const float* b_s = (const float*)d_in[7];
    const float* w_f = (const float*)d_in[8]; const float* b_f = (const float*)d_in[9]; const float* w_out = (const float*)d_in[10];
    float* out = (float*)d_out;
    float* ws = (float*)d_ws; size_t off = 0;
    auto carve = [&](size_t n) { float* r = ws + off; off += (n + 63) & ~(size_t)63; return r; };
    float* cc = carve(GD * GD); float* sc = carve(GD * GD); float* csm = carve((size_t)SEQ * 2 * SEQ);
    float* h = carve((size_t)MG * D); float* p = carve((size_t)MG * DIN); float* vln = carve((size_t)MG * DA); float* mixed = carve((size_t)MG * DA);
    float* a2 = carve((size_t)MG * D); float* zcs = carve((size_t)MG * 2 * DB); float* fq = carve((size_t)MG * DB); float* bfb = carve((size_t)MG * DB); float* y = carve((size_t)MG * D);
    if (off * 4 > ws_size) { fprintf(stderr, "workspace too small\n"); return; }
    hipLaunchKernelGGL(k_chanmat, dim3((GD * GD + 255) / 256), dim3(256), 0, stream, cc, sc);
    hipLaunchKernelGGL(k_seqmat, dim3((unsigned)(((size_t)SEQ * SEQ + 255) / 256)), dim3(256), 0, stream, csm);
    for (int gi = 0; gi < BATCH / GB; ++gi) {
        const float* xg = x + (size_t)gi * MG * D; float* og = out + (size_t)gi * MG * D;
        hipLaunchKernelGGL(k_rmsnorm, dim3(MG / 4), dim3(256), 0, stream, xg, pre_g, h, MG);
        gemm(stream, h, w_in, p, MG, DIN, D, D, DIN, DIN);
        hipLaunchKernelGGL(k_vln, dim3(MG / 4), dim3(256), 0, stream, p, ln_g, ln_b, vln, MG);
        gemm(stream, w_s, vln, mixed, CH, HD, CH, CH, DA, DA, NH, MG / CH, (long)CH * CH, 0, HD, (long)CH * DA, HD, (long)CH * DA);
        hipLaunchKernelGGL(k_agate, dim3((unsigned)(((size_t)MG * DA + 255) / 256)), dim3(256), 0, stream, p, mixed, b_s, a2, MG);
        gemm(stream, p + 3 * DA, cc, zcs, SEQ, GD, GD, DIN, GD, DB, NG, GB, GD, (long)SEQ * DIN, 0, 0, GD, (long)2 * SEQ * DB);
        gemm(stream, p + 3 * DA, sc, zcs + (size_t)SEQ * DB, SEQ, GD, GD, DIN, GD, DB, NG, GB, GD, (long)SEQ * DIN, 0, 0, GD, (long)2 * SEQ * DB);
        gemm(stream, csm, zcs, fq, SEQ, DB, 2 * SEQ, 2 * SEQ, DB, DB, 1, GB, 0, 0, 0, (long)2 * SEQ * DB, 0, (long)SEQ * DB);
        gemm(stream, fq, w_f, bfb, MG, GD, GD, DB, GD, DB, NG, 1, GD, 0, (long)GD * GD, 0, GD, 0);
        hipLaunchKernelGGL(k_bgate, dim3((unsigned)(((size_t)MG * DB + 255) / 256)), dim3(256), 0, stream, p, bfb, b_f, a2, MG);
        gemm(stream, a2, w_out, y, MG, D, D, D, D, D);
        hipLaunchKernelGGL(k_final, dim3(MG / 4), dim3(256), 0, stream, xg, y, post_g, og, MG);
    }
}
```

```cpp
#include <hip/hip_runtime.h>
#include <cstdio>
#include <cstdint>
#include <cstring>

namespace pg8 {
#define PG8_LAS __attribute__((address_space(3)))
typedef unsigned short bf16_t;
typedef short bf16x8 __attribute__((ext_vector_type(8)));
typedef float f32x4 __attribute__((ext_vector_type(4)));
typedef unsigned u32x4 __attribute__((ext_vector_type(4)));
constexpr int BM = 256, BK = 64, HALF = 128, HTB = HALF * BK * 2  , STAGE_BYTES = 8 * HTB, NXCD = 8, WGM = 8;

__host__ __device__ __forceinline__ int lds_byte(int r, int c) { const int st = (r >> 4) * 2 + (c >> 5), rr = r & 15, cc = c & 31, ob = rr * 64 + cc * 2; return st * 1024 + (ob ^ (((ob >> 9) & 1) << 5)); }
__host__ __device__ __forceinline__ void stage_rc(int b, int& R, int& C) { const int st = b / 1024, sb = b % 1024, swz = sb ^ (((sb >> 9) & 1) << 5); R = (st >> 1) * 16 + swz / 64; C = (st & 1) * 32 + (swz % 64) / 2; }
__host__ __device__ __forceinline__ int perm32(int rho) { const int n = rho >> 4, i = rho & 15; return 8 * (i >> 2) + 4 * n + (i & 3); }

struct Unit { int pm, pn; };
struct Gemm { const bf16_t* A; const bf16_t* Bt; int M, N, K; };

struct StaticOrder {
    int nM, nN, nwg, G, c;
    __host__ __device__ void init(int M, int N, int G_, int c_) { nM = M / BM; nN = N / BM; nwg = nM * nN; G = G_; c = c_; }
    __host__ __device__ bool next(int i, Unit& u) const {
        const long L = (long)i * G + c; if (L >= nwg) return false;
        int wgid = (int)L; { const int q = nwg / NXCD, r = nwg % NXCD, xcd = wgid % NXCD, off = wgid / NXCD; wgid = (xcd < r ? xcd * (q + 1) : r * (q + 1) + (xcd - r) * q) + off; }
        const int nig = WGM * nN, gid = wgid / nig, fm = gid * WGM, gsz = (nM - fm) < WGM ? (nM - fm) : WGM;
        u.pm = fm + ((wgid % nig) % gsz); u.pn = (wgid % nig) / gsz; return true;
    }
    __device__ __forceinline__ void a_ready(const Unit&) const {}
    __device__ __forceinline__ void done(const Unit&) const {}
};

typedef float f32x2 __attribute__((ext_vector_type(2)));
__device__ __forceinline__ f32x2 gelu_pk(f32x2 v) {
    const f32x2 av = __builtin_elementwise_abs(v), d = av * 0.2316418882f + 1.0f;
    f32x2 t; t.x = __builtin_amdgcn_rcpf(d.x); t.y = __builtin_amdgcn_rcpf(d.y);
    f32x2 q = t * 0.5307027145f + (-0.7265760135f); q = q * t + 0.7107068705f; q = q * t + (-0.142248368f); q = q * t + 0.127414796f; q = q * t;
    const f32x2 s = (v * v) * (-0.72134752044f);
    f32x2 e; e.x = __builtin_amdgcn_exp2f(s.x); e.y = __builtin_amdgcn_exp2f(s.y);
    const f32x2 m = v * (q * e), r = v - m;
    f32x2 o; o.x = v.x < 0.f ? m.x : r.x; o.y = v.y < 0.f ? m.y : r.y; return o;
}
typedef __bf16 bf16x2_t __attribute__((ext_vector_type(2)));
__device__ __forceinline__ unsigned pk_bf16(float lo, float hi) { const f32x2 f = {lo, hi}; return __builtin_bit_cast(unsigned, __builtin_convertvector(f, bf16x2_t)); }
__device__ __forceinline__ float silu_f(float v) { return v * __builtin_amdgcn_rcpf(1.0f + __builtin_amdgcn_exp2f(-1.44269504089f * v)); }
struct EpiIn {
    static constexpr bool PERM = true, AFTER_DRAIN = false;
    bf16_t *UG, *GV, *Z, *SGB; float* VSTP;
    __device__ __forceinline__ void operator()(const f32x4 (&acc)[2][2][4][2], const Unit& u, int wr, int wc, int fr, int fq) const {
        const int row0 = u.pm * BM + wr * 64 + fr, cl = wc * 32 + 8 * fq;
        if (u.pn < 4) {
            bf16_t* base = UG + (size_t)row0 * 512 + u.pn * 128 + cl;
#pragma unroll
            for (int ai = 0; ai < 2; ++ai)
#pragma unroll
                for (int m = 0; m < 4; ++m) {
                    const f32x4 a0 = acc[ai][0][m][0], a1 = acc[ai][0][m][1], g0 = acc[ai][1][m][0], g1 = acc[ai][1][m][1];
                    const f32x2 p0 = gelu_pk((f32x2){a0[0], a0[1]}), p1 = gelu_pk((f32x2){a0[2], a0[3]}), p2 = gelu_pk((f32x2){a1[0], a1[1]}), p3 = gelu_pk((f32x2){a1[2], a1[3]});
                    u32x4 w;
                    w.x = pk_bf16(p0.x * silu_f(g0[0]), p0.y * silu_f(g0[1])); w.y = pk_bf16(p1.x * silu_f(g0[2]), p1.y * silu_f(g0[3]));
                    w.z = pk_bf16(p2.x * silu_f(g1[0]), p2.y * silu_f(g1[1])); w.w = pk_bf16(p3.x * silu_f(g1[2]), p3.y * silu_f(g1[3]));
                    *(u32x4*)(base + (size_t)(ai * HALF + m * 16) * 512) = w;
                }
        } else if (u.pn < 6) {
            bf16_t* base = GV + (size_t)row0 * 512 + (u.pn - 4) * 256 + cl;
            float* sp = VSTP + (size_t)row0 * 16 + ((u.pn - 4) * 4 + wc) * 2;
#pragma unroll
            for (int ai = 0; ai < 2; ++ai)
#pragma unroll
                for (int m = 0; m < 4; ++m) {
                    float s = 0.f, q = 0.f;
#pragma unroll
                    for (int bj = 0; bj < 2; ++bj) {
                        const f32x4 a0 = acc[ai][bj][m][0], a1 = acc[ai][bj][m][1];
                        const f32x2 p0 = gelu_pk((f32x2){a0[0], a0[1]}), p1 = gelu_pk((f32x2){a0[2], a0[3]}), p2 = gelu_pk((f32x2){a1[0], a1[1]}), p3 = gelu_pk((f32x2){a1[2], a1[3]});
                        s += ((p0.x + p0.y) + (p1.x + p1.y)) + ((p2.x + p2.y) + (p3.x + p3.y));
                        q += ((p0.x * p0.x + p0.y * p0.y) + (p1.x * p1.x + p1.y * p1.y)) + ((p2.x * p2.x + p2.y * p2.y) + (p3.x * p3.x + p3.y * p3.y));
                        u32x4 w; w.x = pk_bf16(p0.x, p0.y); w.y = pk_bf16(p1.x, p1.y); w.z = pk_bf16(p2.x, p2.y); w.w = pk_bf16(p3.x, p3.y);
                        *(u32x4*)(base + (size_t)(ai * HALF + m * 16) * 512 + bj * HALF) = w;
                    }
                    s += __shfl_xor(s, 16); s += __shfl_xor(s, 32); q += __shfl_xor(q, 16); q += __shfl_xor(q, 32);
                    if (fq == 0) *(f32x2*)(sp + (size_t)(ai * HALF + m * 16) * 16) = (f32x2){s, q};
                }
        } else {
            const bool act = u.pn >= 8;
            bf16_t* base = (act ? SGB + (size_t)(u.pn - 8) * 256 : Z + (size_t)(u.pn - 6) * 256) + (size_t)row0 * 512 + cl;
#pragma unroll
            for (int ai = 0; ai < 2; ++ai)
#pragma unroll
                for (int m = 0; m < 4; ++m)
#pragma unroll
                    for (int bj = 0; bj < 2; ++bj) {
                        f32x4 a0 = acc[ai][bj][m][0], a1 = acc[ai][bj][m][1];
                        if (act) { a0 = (f32x4){silu_f(a0[0]), silu_f(a0[1]), silu_f(a0[2]), silu_f(a0[3])}; a1 = (f32x4){silu_f(a1[0]), silu_f(a1[1]), silu_f(a1[2]), silu_f(a1[3])}; }
                        u32x4 w; w.x = pk_bf16(a0[0], a0[1]); w.y = pk_bf16(a0[2], a0[3]); w.z = pk_bf16(a1[0], a1[1]); w.w = pk_bf16(a1[2], a1[3]);
                        *(u32x4*)(base + (size_t)(ai * HALF + m * 16) * 512 + bj * HALF) = w;
                    }
        }
    }
};
struct EpiY {
    static constexpr bool PERM = true, AFTER_DRAIN = false;
    bf16_t* Y; float* YSQ;
    __device__ __forceinline__ void operator()(const f32x4 (&acc)[2][2][4][2], const Unit& u, int wr, int wc, int fr, int fq) const {
        const int row0 = u.pm * BM + wr * 64 + fr, cl = wc * 32 + 8 * fq;
        bf16_t* base = Y + (size_t)row0 * 1024 + u.pn * 256 + cl;
        float* sp = YSQ + (size_t)row0 * 16 + u.pn * 4 + wc;
#pragma unroll
        for (int ai = 0; ai < 2; ++ai)
#pragma unroll
            for (int m = 0; m < 4; ++m) {
                float q = 0.f;
#pragma unroll
                for (int bj = 0; bj < 2; ++bj) {
                    const f32x4 a0 = acc[ai][bj][m][0], a1 = acc[ai][bj][m][1];
                    q += ((a0[0] * a0[0] + a0[1] * a0[1]) + (a0[2] * a0[2] + a0[3] * a0[3])) + ((a1[0] * a1[0] + a1[1] * a1[1]) + (a1[2] * a1[2] + a1[3] * a1[3]));
                    u32x4 w; w.x = pk_bf16(a0[0], a0[1]); w.y = pk_bf16(a0[2], a0[3]); w.z = pk_bf16(a1[0], a1[1]); w.w = pk_bf16(a1[2], a1[3]);
                    *(u32x4*)(base + (size_t)(ai * HALF + m * 16) * 1024 + bj * HALF) = w;
                }
                q += __shfl_xor(q, 16); q += __shfl_xor(q, 32);
                if (fq == 0) sp[(size_t)(ai * HALF + m * 16) * 16] = q;
            }
    }
};
struct PanelOrder {
    int G, c, nM, nN;
    __device__ __forceinline__ bool next(int i, Unit& u) const { const int pm = c + G * (i / nN); if (pm >= nM) return false; u.pm = pm; u.pn = i % nN; return true; }
    __device__ __forceinline__ void a_ready(const Unit&) const {}
    __device__ __forceinline__ void done(const Unit&) const {}
};


template <class Epi, class Sched, bool ALIGN_EPI = false, bool SP2 = false>
__device__ __forceinline__ void gemm_phase(PG8_LAS unsigned char* lds, const Gemm g, const Sched& S, const Epi& E) {
    const int tid = threadIdx.x, wid = __builtin_amdgcn_readfirstlane(tid >> 6), lane = tid & 63, wr = wid >> 2, wc = wid & 3, fr = lane & 15, fq = lane >> 4;
    const int K = g.K, nt = K / BK;
    unsigned voffA[2], voffB[2];
#pragma unroll
    for (int i = 0; i < 2; ++i) { int R, C; stage_rc(tid * 16 + i * 8192, R, C); const int Rb = Epi::PERM ? ((R & ~31) + perm32(R & 31)) : R;
        voffA[i] = (unsigned)(R * K + C) * 2u; voffB[i] = (unsigned)(Rb * K + C) * 2u; }
    const size_t kstep = (size_t)(BK * 2);
    const size_t hstep = (size_t)HALF * K * 2;
    const size_t tstep = 2 * hstep;
    const unsigned ldsw = (unsigned)wid * 1024u;
    const int aoff = lds_byte(wr * 64 + fr, fq * 8), boff = lds_byte(wc * 32 + fr, fq * 8);
#define PG8_SA(b, h) (((b) * 2 + (h)) * HTB)
#define PG8_SB(b, h) ((4 + (b) * 2 + (h)) * HTB)
#define PG8_STAGE(bufoff, gbase, voff) do { _Pragma("unroll") for (int _i = 0; _i < 2; ++_i) \
        __builtin_amdgcn_global_load_lds((const unsigned*)((const char*)(gbase) + (voff)[_i]), (PG8_LAS unsigned*)(lds + (bufoff) + ldsw + _i * 8192), 16, 0, 0); } while (0)
#define PG8_LDA(dst, b, h) do { _Pragma("unroll") for (int m = 0; m < 4; ++m) _Pragma("unroll") for (int k = 0; k < 2; ++k) dst[m][k] = *(const PG8_LAS bf16x8*)(lds + PG8_SA(b, h) + aoff + m * 2048 + k * 1024); } while (0)
#define PG8_LDB(dst, b, h) do { _Pragma("unroll") for (int n = 0; n < 2; ++n) _Pragma("unroll") for (int k = 0; k < 2; ++k) dst[n][k] = *(const PG8_LAS bf16x8*)(lds + PG8_SB(b, h) + boff + n * 2048 + k * 1024); } while (0)
#define PG8_MMA(ai, bj, At, Bt) do { __builtin_amdgcn_s_setprio(1); _Pragma("unroll") for (int m = 0; m < 4; ++m) _Pragma("unroll") for (int n = 0; n < 2; ++n) _Pragma("unroll") for (int k = 0; k < 2; ++k) \
        acc[ai][bj][m][n] = __builtin_amdgcn_mfma_f32_16x16x32_bf16(Bt[n][k], At[m][k], acc[ai][bj][m][n], 0, 0, 0); __builtin_amdgcn_s_setprio(0); } while (0)
#define PG8_WAIT_V(n) asm volatile("s_waitcnt vmcnt(" #n ")" ::: "memory")
#define PG8_WAIT_L(n) asm volatile("s_waitcnt lgkmcnt(" #n ")" ::: "memory")
#define PG8_BAR __builtin_amdgcn_s_barrier()
#define PG8_SCHED __builtin_amdgcn_sched_barrier(0)
    Unit cur, nxt; int ui = 0;
    if (!S.next(0, cur)) return;
    f32x4 acc[2][2][4][2];
#pragma unroll
    for (int a = 0; a < 2; ++a)
#pragma unroll
        for (int b = 0; b < 2; ++b)
#pragma unroll
            for (int m = 0; m < 4; ++m)
#pragma unroll
                for (int n = 0; n < 2; ++n) acc[a][b][m][n] = (f32x4){0.f, 0.f, 0.f, 0.f};
    bf16x8 At[4][2], B0[2][2], B1[2][2];
    const char* cA = (const char*)g.A + (size_t)cur.pm * tstep; const char* cB = (const char*)g.Bt + (size_t)cur.pn * tstep;
    S.a_ready(cur);
    if constexpr (SP2) {
        PG8_STAGE(PG8_SB(0, 0), cB, voffB); PG8_STAGE(PG8_SB(0, 1), cB + hstep, voffB); PG8_STAGE(PG8_SA(0, 0), cA, voffA); PG8_STAGE(PG8_SA(0, 1), cA + hstep, voffA);
        if (wr == 1) PG8_BAR;
        PG8_WAIT_V(2); PG8_BAR;
        PG8_STAGE(PG8_SB(1, 0), cB + kstep, voffB); PG8_STAGE(PG8_SA(1, 0), cA + kstep, voffA); PG8_STAGE(PG8_SB(1, 1), cB + hstep + kstep, voffB);
        PG8_WAIT_V(6); PG8_BAR;
    } else {
        PG8_STAGE(PG8_SB(0, 0), cB, voffB); PG8_STAGE(PG8_SA(0, 0), cA, voffA); PG8_STAGE(PG8_SB(0, 1), cB + hstep, voffB); PG8_STAGE(PG8_SA(0, 1), cA + hstep, voffA);
        if (wr == 1) PG8_BAR;
        PG8_WAIT_V(4); PG8_BAR;
        PG8_STAGE(PG8_SB(1, 0), cB + kstep, voffB); PG8_STAGE(PG8_SA(1, 0), cA + kstep, voffA); PG8_STAGE(PG8_SB(1, 1), cB + hstep + kstep, voffB);
        PG8_WAIT_V(6); PG8_BAR;
    }
    for (;;) {
        const bool has_next = S.next(ui + 1, nxt);
        const char* nA = has_next ? (const char*)g.A + (size_t)nxt.pm * tstep : cA; const char* nB = has_next ? (const char*)g.Bt + (size_t)nxt.pn * tstep : cB;
        for (int t = 0; t < nt; t += 2) {
            const bool last = (t == nt - 2);
            const char* a1 = cA + (size_t)(t + 1) * kstep;
            const char* a2 = last ? nA : cA + (size_t)(t + 2) * kstep; const char* b2 = last ? nB : cB + (size_t)(t + 2) * kstep;
            const char* a3 = a2 + kstep; const char* b3 = b2 + kstep;
            if (last && has_next) S.a_ready(nxt);
            if constexpr (SP2) {
            PG8_LDB(B0, 0, 0); PG8_LDB(B1, 0, 1); PG8_SCHED; PG8_LDA(At, 0, 0); PG8_STAGE(PG8_SA(1, 1), a1 + hstep, voffA);
            PG8_WAIT_V(8); PG8_WAIT_L(0); PG8_BAR; PG8_MMA(0, 0, At, B0); PG8_MMA(0, 1, At, B1); PG8_BAR; PG8_SCHED;
            PG8_LDA(At, 0, 1); PG8_STAGE(PG8_SB(0, 0), b2, voffB); PG8_STAGE(PG8_SB(0, 1), b2 + hstep, voffB); PG8_STAGE(PG8_SA(0, 0), a2, voffA);
            PG8_WAIT_V(8); PG8_WAIT_L(0); PG8_BAR; PG8_MMA(1, 0, At, B0); PG8_MMA(1, 1, At, B1); PG8_BAR; PG8_SCHED;
            PG8_LDB(B0, 1, 0); PG8_LDB(B1, 1, 1); PG8_SCHED; PG8_LDA(At, 1, 0); PG8_STAGE(PG8_SA(0, 1), a2 + hstep, voffA);
            PG8_WAIT_V(8); PG8_WAIT_L(0); PG8_BAR; PG8_MMA(0, 0, At, B0); PG8_MMA(0, 1, At, B1); PG8_BAR; PG8_SCHED;
            PG8_LDA(At, 1, 1); PG8_STAGE(PG8_SB(1, 0), b3, voffB); PG8_STAGE(PG8_SB(1, 1), b3 + hstep, voffB); PG8_STAGE(PG8_SA(1, 0), a3, voffA);
            PG8_WAIT_V(8); PG8_WAIT_L(0); PG8_BAR; PG8_MMA(1, 0, At, B0); PG8_MMA(1, 1, At, B1); PG8_BAR; PG8_SCHED;
            } else {
            PG8_LDB(B0, 0, 0); PG8_SCHED; PG8_LDA(At, 0, 0); PG8_STAGE(PG8_SA(1, 1), a1 + hstep, voffA);
            PG8_WAIT_L(8); PG8_BAR; PG8_WAIT_L(0); PG8_MMA(0, 0, At, B0); PG8_BAR; PG8_SCHED;
            PG8_LDB(B1, 0, 1); PG8_STAGE(PG8_SB(0, 0), b2, voffB);
            PG8_BAR; PG8_WAIT_L(0); PG8_MMA(0, 1, At, B1); PG8_BAR;
            PG8_LDA(At, 0, 1); PG8_STAGE(PG8_SA(0, 0), a2, voffA);
            PG8_BAR; PG8_WAIT_L(0); PG8_MMA(1, 0, At, B0); PG8_BAR; PG8_SCHED;
            PG8_STAGE(PG8_SB(0, 1), b2 + hstep, voffB);
            PG8_WAIT_V(6); PG8_BAR; PG8_MMA(1, 1, At, B1); PG8_BAR;
            PG8_LDB(B0, 1, 0); PG8_SCHED; PG8_LDA(At, 1, 0); PG8_STAGE(PG8_SA(0, 1), a2 + hstep, voffA);
            PG8_WAIT_L(8); PG8_BAR; PG8_WAIT_L(0); PG8_MMA(0, 0, At, B0); PG8_BAR; PG8_SCHED;
            PG8_LDB(B1, 1, 1); PG8_STAGE(PG8_SB(1, 0), b3, voffB);
            PG8_BAR; PG8_WAIT_L(0); PG8_MMA(0, 1, At, B1); PG8_BAR;
            PG8_LDA(At, 1, 1); PG8_STAGE(PG8_SA(1, 0), a3, voffA);
            PG8_BAR; PG8_WAIT_L(0); PG8_MMA(1, 0, At, B0); PG8_BAR; PG8_SCHED;
            PG8_STAGE(PG8_SB(1, 1), b3 + hstep, voffB);
            PG8_WAIT_V(6); PG8_BAR; PG8_MMA(1, 1, At, B1); PG8_BAR;
            }
        }
        if constexpr (ALIGN_EPI) { if (wr == 0) PG8_BAR; }
        if constexpr (!Epi::AFTER_DRAIN) { E(acc, cur, wr, wc, fr, fq); S.done(cur); }
        if (!has_next) break;
#pragma unroll
        for (int a = 0; a < 2; ++a)
#pragma unroll
            for (int b = 0; b < 2; ++b)
#pragma unroll
                for (int m = 0; m < 4; ++m)
#pragma unroll
                    for (int n = 0; n < 2; ++n) acc[a][b][m][n] = (f32x4){0.f, 0.f, 0.f, 0.f};
        cur = nxt; cA = nA; cB = nB; ++ui;
        if constexpr (ALIGN_EPI) { if (wr == 1) PG8_BAR; }
    }
    PG8_WAIT_V(0);
    if constexpr (!ALIGN_EPI) { if (wr == 0) PG8_BAR; }
    PG8_BAR;
    if constexpr (Epi::AFTER_DRAIN) { E.fused(acc, cur, wr, wc, fr, fq, lds, wid, lane); S.done(cur); }
#undef PG8_SA
#undef PG8_SB
#undef PG8_STAGE
#undef PG8_LDA
#undef PG8_LDB
#undef PG8_MMA
#undef PG8_WAIT_V
#undef PG8_WAIT_L
#undef PG8_BAR
#undef PG8_SCHED
}
}
constexpr int NWAVES = 8;
#ifndef MK_N_LAUNCHES
#define MK_N_LAUNCHES 1
#endif
constexpr int N_LAUNCHES = MK_N_LAUNCHES;
constexpr int PER_PHASE = 5;
#ifndef PROBE_REPEAT
#define PROBE_REPEAT -1
#endif

constexpr int BATCH = 32, SEQ = 2048, D = 1024, DA = 512, DB = 512, DIN = 2560;
constexpr int M = BATCH * SEQ;
constexpr float EPS = 1e-6f;

constexpr size_t MiB = 1u << 20;
constexpr size_t WS_CTL = 0, CTL_ZERO_BYTES = 1 * MiB;
constexpr size_t WS_WIN = 2 * MiB;
constexpr size_t WS_WOUT = 8 * MiB;
constexpr size_t WS_WSB = 10 * MiB;
constexpr size_t WS_MT = 11 * MiB;
constexpr size_t WS_ECS = 12 * MiB;
constexpr size_t WS_MTF = 13 * MiB;
constexpr size_t WS_VSTP = 14 * MiB;
constexpr size_t WS_YSQ = 18 * MiB;
constexpr size_t WS_H = 32 * MiB;
constexpr size_t WS_UG = 160 * MiB;
constexpr size_t WS_GV = 224 * MiB;
constexpr size_t WS_Z = 288 * MiB;
constexpr size_t WS_SGB = 352 * MiB;
constexpr size_t WS_X1 = 416 * MiB;
constexpr size_t WS_A2 = 480 * MiB;
constexpr size_t WS_Y = 608 * MiB;
constexpr size_t WS_END = 736 * MiB;
constexpr int CW_TMO = 0, CW_CODE = 1, CW_BAR = 4096;

constexpr int RING_OFF = 0, RING_BYTES = 131072;
constexpr int LDSCTL_OFF = RING_BYTES, MISC_OFF = LDSCTL_OFF + 320;
constexpr int LDS_BYTES = 147456;
static_assert(MISC_OFF + 128 <= LDS_BYTES, "LDS map");


#define GAS __attribute__((address_space(1)))
#define LAS __attribute__((address_space(3)))
typedef unsigned short bf16;
typedef unsigned v4u __attribute__((ext_vector_type(4)));
typedef float f32x4 __attribute__((ext_vector_type(4)));
typedef short bf16x8 __attribute__((ext_vector_type(8)));
typedef GAS unsigned gu32;
typedef GAS unsigned long long gu64;
#define RLX_AGENT __ATOMIC_RELAXED, __HIP_MEMORY_SCOPE_AGENT
#define LDS_WAIT() asm volatile("s_waitcnt lgkmcnt(0)" ::: "memory")
#define VM_WAIT() asm volatile("s_waitcnt vmcnt(0)" ::: "memory")
__device__ __forceinline__ unsigned long long rt() { return __builtin_amdgcn_s_memrealtime(); }
__device__ __forceinline__ unsigned f2bf(float f) { unsigned u = __builtin_bit_cast(unsigned, f); return (u + 0x7fffu + ((u >> 16) & 1u)) >> 16; }
__device__ __forceinline__ unsigned pk2(float lo, float hi) { return f2bf(lo) | (f2bf(hi) << 16); }
#define XB_TMO      128
#define XB_XCNT(j)  (256  + 64 * (j))
#define XB_XSUB(j)  (1280 + 64 * (j))
#define XB_XGEN(j)  (2304 + 64 * (j))
#define XB_TOP      3328
#define XB_TOPGEN   3392
#define XCD_BAR_WORDS 3456
#define XB_SPIN_CAP (1u << 18)

__device__ __forceinline__ unsigned xb_ld(unsigned* p)              { return __hip_atomic_load(p, __ATOMIC_RELAXED, __HIP_MEMORY_SCOPE_AGENT); }
__device__ __forceinline__ unsigned xb_add(unsigned* p, unsigned v) { return __hip_atomic_fetch_add(p, v, __ATOMIC_RELAXED, __HIP_MEMORY_SCOPE_AGENT); }
__device__ __forceinline__ unsigned xb_xcc_id() { return (unsigned)__builtin_amdgcn_s_getreg((3 << 11) | 20) & 0xFu; }
#define XB_SPIN(cond, bar) do { unsigned _sp = 0; while (cond) { __builtin_amdgcn_s_sleep(1); \
    if ((++_sp & 255u) == 0u) { if (xb_ld(&(bar)[XB_TMO])) break; if (_sp > XB_SPIN_CAP) { atomicAdd(&(bar)[XB_TMO], 1u); break; } } } } while (0)

struct XcdBarrier {
    unsigned* bar; unsigned x;
    volatile LAS unsigned* st;
};

__device__ __forceinline__ XcdBarrier xcd_barrier_post(unsigned* bar, volatile LAS unsigned* st) {
    XcdBarrier b; b.bar = bar; b.x = xb_xcc_id(); b.st = st;
    if (threadIdx.x == 0) (void)xb_add(&bar[XB_XCNT(b.x)], 1u);
    return b;
}
__device__ __forceinline__ void xcd_barrier_complete(unsigned* bar, unsigned x, unsigned& nloc, unsigned& nx) {
    const unsigned G = gridDim.x * gridDim.y * gridDim.z;
    unsigned sum, cnt, mine, sp = 0u;
    for (;;) {
        sum = 0u; cnt = 0u; mine = 0u;
#pragma unroll
        for (unsigned j = 0; j < 16; ++j) { const unsigned c = xb_ld(&bar[XB_XCNT(j)]); sum += c; cnt += (c > 0u) ? 1u : 0u; mine = (j == x) ? c : mine; }
        if (sum == G) break;
        __builtin_amdgcn_s_sleep(1);
        if ((++sp & 255u) == 0u) { if (xb_ld(&bar[XB_TMO])) break; if (sp > XB_SPIN_CAP) { atomicAdd(&bar[XB_TMO], 1u); break; } }
    }
    nloc = mine > 0u ? mine : 1u; nx = cnt > 0u ? cnt : 1u;
}

__device__ __forceinline__ void xcd_barrier(const XcdBarrier& b) {
    asm volatile("s_waitcnt vmcnt(0)" ::: "memory");
    __syncthreads();
    if (threadIdx.x == 0) {
        unsigned* bar = b.bar;
        __builtin_amdgcn_s_waitcnt(0);
        unsigned nloc = b.st[0], nx = b.st[1];
        if (nloc == 0u) { xcd_barrier_complete(bar, b.x, nloc, nx); b.st[0] = nloc; b.st[1] = nx; }
        const unsigned old = xb_add(&bar[XB_XSUB(b.x)], 1u);
        const unsigned gen = old / nloc;
        if (old + 1u == (gen + 1u) * nloc) {
            __builtin_amdgcn_fence(__ATOMIC_RELEASE, "agent");
            asm volatile("s_waitcnt vmcnt(0)" ::: "memory");
            const unsigned og = xb_add(&bar[XB_TOP], 1u);
            const unsigned tg = og / nx;
            if (og + 1u == (tg + 1u) * nx) xb_add(&bar[XB_TOPGEN], 1u);
            else XB_SPIN(xb_ld(&bar[XB_TOPGEN]) == tg, bar);
            __builtin_amdgcn_fence(__ATOMIC_ACQUIRE, "agent");
            xb_add(&bar[XB_XGEN(b.x)], 1u);
            asm volatile("s_waitcnt vmcnt(0)" ::: "memory");
        } else {
            XB_SPIN(xb_ld(&bar[XB_XGEN(b.x)]) == gen, bar);
            __builtin_amdgcn_fence(__ATOMIC_ACQUIRE, "agent");
            asm volatile("s_waitcnt vmcnt(0)" ::: "memory");
        }
    }
    __syncthreads();
}
typedef float f32x2 __attribute__((ext_vector_type(2)));
typedef float f32x16 __attribute__((ext_vector_type(16)));
typedef unsigned u32x2 __attribute__((ext_vector_type(2)));
using pg8::pk_bf16;
struct Frame {
    LAS unsigned char* lds;
    volatile LAS unsigned* MISC;
    gu32* ctl;
    int tid, lane, wave;
    int vcu, G;
    const float *x, *pre_g, *post_g, *w_in, *ln_g, *ln_b, *w_s, *b_s, *w_f, *b_f, *w_out; float* out;
    bf16 *WIN, *WOUT, *WSB, *MT, *MTF, *ECS, *H, *UG, *GV, *Z, *SGB, *X1, *A2, *Y;
    float *VSTP, *YSQ;
};
__device__ __forceinline__ float bflo(unsigned w) { return __builtin_bit_cast(float, w << 16); }
__device__ __forceinline__ float bfhi(unsigned w) { return __builtin_bit_cast(float, w & 0xffff0000u); }
__device__ __forceinline__ float wave_sum(float v) {
#pragma unroll
    for (int o = 1; o < 64; o <<= 1) v += __shfl_xor(v, o);
    return v;
}
__device__ __forceinline__ int win_src_col(int n) { const int t = n >> 8, r = n & 255; return t < 4 ? (r < 128 ? t * 128 + r : 1024 + t * 128 + (r - 128)) : (t < 6 ? 512 + (t - 4) * 256 + r : (t < 8 ? 1536 + (t - 6) * 256 + r : 2048 + (t - 8) * 256 + r)); }
__device__ __forceinline__ void p0_transpose_item(const float* W, int K, int N, bf16* WT, const float* kscale, bool remap, LAS float* scr, int item, int lane) {
    const int nblk = N / 32, kb = item / nblk, nb = item % nblk, k0 = 64 * kb, n0 = 32 * nb, s0 = remap ? win_src_col(n0) : n0;
#pragma unroll 8
    for (int i = 0; i < 32; ++i) { const int kk = 2 * i + (lane >> 5); float v = W[(size_t)(k0 + kk) * N + s0 + (lane & 31)]; if (kscale) v *= kscale[k0 + kk]; scr[kk * 33 + (lane & 31)] = v; }
    LDS_WAIT(); asm volatile("" ::: "memory");
    const int c = lane & 7;
#pragma unroll
    for (int j = 0; j < 4; ++j) { const int n = (lane >> 3) + 8 * j; const LAS float* s = scr + (8 * c) * 33 + n;
        v4u o; o.x = pk_bf16(s[0 * 33], s[1 * 33]); o.y = pk_bf16(s[2 * 33], s[3 * 33]); o.z = pk_bf16(s[4 * 33], s[5 * 33]); o.w = pk_bf16(s[6 * 33], s[7 * 33]);
        *(GAS v4u*)(WT + (size_t)(n0 + n) * K + k0 + 8 * c) = o; }
    LDS_WAIT(); asm volatile("" ::: "memory");
}
__device__ __forceinline__ void rms_rows4_to_bf16(Frame& F, const float* xrow, bf16* orow) {
    f32x4 v[4][4]; float s[4];
#pragma unroll
    for (int i = 0; i < 4; ++i) { const GAS f32x4* xr = (const GAS f32x4*)(xrow + (size_t)i * D) + F.lane;
#pragma unroll
        for (int j = 0; j < 4; ++j) v[i][j] = xr[64 * j]; }
#pragma unroll
    for (int i = 0; i < 4; ++i) { s[i] = 0.f;
#pragma unroll
        for (int j = 0; j < 4; ++j) s[i] += (v[i][j].x * v[i][j].x + v[i][j].y * v[i][j].y) + (v[i][j].z * v[i][j].z + v[i][j].w * v[i][j].w); }
#pragma unroll
    for (int o = 1; o < 64; o <<= 1) {
#pragma unroll
        for (int i = 0; i < 4; ++i) s[i] += __shfl_xor(s[i], o); }
#pragma unroll
    for (int i = 0; i < 4; ++i) { const float r = rsqrtf(s[i] * (1.f / D) + EPS); GAS u32x2* o8 = (GAS u32x2*)(orow + (size_t)i * D) + F.lane;
#pragma unroll
        for (int j = 0; j < 4; ++j) o8[64 * j] = (u32x2){pk_bf16(v[i][j].x * r, v[i][j].y * r), pk_bf16(v[i][j].z * r, v[i][j].w * r)}; }
}
__device__ __forceinline__ void p0_prologue(Frame& F) {
    LAS float* scr = (LAS float*)(F.lds + RING_OFF + F.wave * 16384);
    const int gw = F.vcu * NWAVES + F.wave, NGW = F.G * NWAVES;
    constexpr int I_IN = (D / 64) * (DIN / 32), I_OUT = (D / 64) * (D / 32);
    for (int it = gw; it < I_IN + I_OUT; it += NGW) {
        if (it < I_IN) p0_transpose_item(F.w_in, D, DIN, F.WIN, F.pre_g, true, scr, it, F.lane);
        else p0_transpose_item(F.w_out, D, D, F.WOUT, nullptr, false, scr, it - I_IN, F.lane);
    }
    const int gt = gw * 64 + F.lane, NT = NGW * 64;
    for (int i = gt; i < 4 * 128 * 128 / 2; i += NT) { const f32x2 v = *(const f32x2*)(F.w_s + 2 * i); ((unsigned*)F.WSB)[i] = pk_bf16(v.x, v.y); }
    for (int i = gt; i < 16 * 4 * 16 * 64; i += NT) {
        const int ln = i & 63, scs = (i >> 6) & 15, kt = (i >> 10) & 3, k1 = i >> 12, k2 = 32 * kt + (ln & 31), h = ln >> 5, st = scs >> 2, c = (scs >> 1) & 1, s = scs & 1;
        float v[8];
#pragma unroll
        for (int j = 0; j < 8; ++j) { const int sl = 32 * st + 16 * s + 8 * (j >> 2) + 4 * h + (j & 3); const int idx = ((k1 + 16 * k2) * sl) & 2047; float sn, cs; sincospif((float)idx * (1.0f / 1024.0f), &sn, &cs); v[j] = c ? sn : cs; }
        v4u o; o.x = pk_bf16(v[0], v[1]); o.y = pk_bf16(v[2], v[3]); o.z = pk_bf16(v[4], v[5]); o.w = pk_bf16(v[6], v[7]);
        *(v4u*)(F.ECS + (size_t)i * 8) = o;
    }
    {   LAS float* ctab = (LAS float*)(F.lds + RING_OFF + F.wave * 16384 + 12288);
        { float sn, cs; sincospif((float)F.lane * (1.0f / 64.0f), &sn, &cs); ctab[F.lane] = cs; ctab[64 + F.lane] = -cs; }
        LDS_WAIT(); asm volatile("" ::: "memory");
        for (int i = gt; i < 4 * 128 * 128; i += NT) {
            const int c = i & 127, e = (i >> 7) & 127, g = i >> 14; float wc = 0.f, ws = 0.f; const float* wf = F.w_f + (size_t)g * 16384 + e;
#pragma unroll 8
            for (int m = 0; m < 128; ++m) { const int ph = (c * m) & 127; const float w = wf[(size_t)m * 128]; wc += ctab[ph] * w; ws += ctab[(ph + 96) & 127] * w; }
            wc *= (1.0f / 512.0f); ws *= (1.0f / 512.0f);
            unsigned short* mt = (unsigned short*)F.MT + (size_t)g * 65536;
            const unsigned pc = pk_bf16(wc, -ws);
            mt[(size_t)e * 256 + c] = (unsigned short)pc; mt[(size_t)e * 256 + 128 + c] = (unsigned short)(pk_bf16(ws, 0.f));
            mt[(size_t)(128 + e) * 256 + c] = (unsigned short)(pc >> 16); mt[(size_t)(128 + e) * 256 + 128 + c] = (unsigned short)pc;
        }
        LDS_WAIT(); asm volatile("" ::: "memory");
    }
    for (int m = 4 * gw; m < M; m += 4 * NGW) rms_rows4_to_bf16(F, F.x + (size_t)m * D, F.H + (size_t)m * D);
}

__device__ __forceinline__ int lnt_key(int c) { return ((c ^ (c >> 5)) & 1) | (((c >> 3) & 3) << 1) | (((c >> 1) & 1) << 3); }
__device__ __forceinline__ int lnt_off(int c, int qchunk) { return c * 256 + ((qchunk ^ lnt_key(c)) << 4); }
__device__ __forceinline__ void p2_spatial(Frame& F, int ci) {
    LAS unsigned char* lnt = F.lds;
    LAS float* st_mu = (LAS float*)(F.lds + 32768);
    LAS float* st_rs = st_mu + 128;
    const int m0 = ci * 128, tid = F.tid, lane = F.lane, w = F.wave;
    if (tid < 128) {
        const float* sp = F.VSTP + (size_t)(m0 + tid) * 16; float s = 0.f, q = 0.f;
#pragma unroll
        for (int i = 0; i < 8; ++i) { s += sp[2 * i]; q += sp[2 * i + 1]; }
        const float mu = s * (1.f / DA), var = fmaxf(q * (1.f / DA) - mu * mu, 0.f);
        st_mu[tid] = mu; st_rs[tid] = rsqrtf(var + EPS);
    }
    __syncthreads();
    const int cg = lane & 15, tq = lane >> 4, q0 = 16 * w + 4 * tq;
    const int fr = lane & 15, fq = lane >> 4, wcb = (w & 3) * 32, ph = (w >> 2) * 64;
    float mu4[4], rs4[4];
#pragma unroll
    for (int i = 0; i < 4; ++i) { mu4[i] = st_mu[q0 + i]; rs4[i] = st_rs[q0 + i]; }
    for (int h = 0; h < 4; ++h) {
        {
            v4u raw[4];
#pragma unroll
            for (int i = 0; i < 4; ++i) raw[i] = *(const v4u*)(F.GV + (size_t)(m0 + q0 + i) * 512 + h * 128 + 8 * cg);
            const f32x4 g0 = *(const f32x4*)(F.ln_g + h * 128 + 8 * cg), g1 = *(const f32x4*)(F.ln_g + h * 128 + 8 * cg + 4);
            const f32x4 b0 = *(const f32x4*)(F.ln_b + h * 128 + 8 * cg), b1 = *(const f32x4*)(F.ln_b + h * 128 + 8 * cg + 4);
#pragma unroll
            for (int j = 0; j < 8; ++j) {
                const float gg = j < 4 ? g0[j & 3] : g1[j & 3], bb = j < 4 ? b0[j & 3] : b1[j & 3];
                float v[4];
#pragma unroll
                for (int i = 0; i < 4; ++i) { const unsigned wd = raw[i][j >> 1]; const float xv = (j & 1) ? bfhi(wd) : bflo(wd); v[i] = (xv - mu4[i]) * rs4[i] * gg + bb; }
                const int c = 8 * cg + j;
                *(LAS u32x2*)(lnt + lnt_off(c, q0 >> 3) + (q0 & 7) * 2) = (u32x2){pk_bf16(v[0], v[1]), pk_bf16(v[2], v[3])};
            }
        }
        __syncthreads();
        f32x4 acc[2][4];
#pragma unroll
        for (int n = 0; n < 2; ++n)
#pragma unroll
            for (int t = 0; t < 4; ++t) acc[n][t] = (f32x4){0.f, 0.f, 0.f, 0.f};
#pragma unroll
        for (int ks = 0; ks < 4; ++ks) {
            bf16x8 a[2];
#pragma unroll
            for (int n = 0; n < 2; ++n) { const int c = wcb + 8 * (fr >> 2) + 4 * n + (fr & 3); a[n] = *(const LAS bf16x8*)(lnt + lnt_off(c, 4 * ks + fq)); }
#pragma unroll
            for (int t = 0; t < 4; ++t) {
                const bf16x8 bw = *(const bf16x8*)(F.WSB + (size_t)(h * 128 + ph + 16 * t + fr) * 128 + 32 * ks + 8 * fq);
#pragma unroll
                for (int n = 0; n < 2; ++n) acc[n][t] = __builtin_amdgcn_mfma_f32_16x16x32_bf16(a[n], bw, acc[n][t], 0, 0, 0);
            }
        }
#pragma unroll
        for (int t = 0; t < 4; ++t) {
            const int p = ph + 16 * t + fr; const float bs = F.b_s[h * 128 + p];
            const v4u ug = *(const v4u*)(F.UG + (size_t)(m0 + p) * 512 + h * 128 + wcb + 8 * fq);
            v4u o;
            o.x = pk_bf16((acc[0][t][0] + bs) * bflo(ug.x), (acc[0][t][1] + bs) * bfhi(ug.x)); o.y = pk_bf16((acc[0][t][2] + bs) * bflo(ug.y), (acc[0][t][3] + bs) * bfhi(ug.y));
            o.z = pk_bf16((acc[1][t][0] + bs) * bflo(ug.z), (acc[1][t][1] + bs) * bfhi(ug.z)); o.w = pk_bf16((acc[1][t][2] + bs) * bflo(ug.w), (acc[1][t][3] + bs) * bfhi(ug.w));
            *(v4u*)(F.A2 + (size_t)(m0 + p) * 1024 + h * 128 + wcb + 8 * fq) = o;
        }
        __syncthreads();
    }
}
__device__ __forceinline__ void dft16(const float (&z)[16], float (&r)[16]) {
    constexpr float C16[16] = {1.f, 0.92387953251f, 0.70710678119f, 0.38268343237f, 0.f, -0.38268343237f, -0.70710678119f, -0.92387953251f, -1.f, -0.92387953251f, -0.70710678119f, -0.38268343237f, 0.f, 0.38268343237f, 0.70710678119f, 0.92387953251f};
    float e[8], o[8];
#pragma unroll
    for (int s = 1; s < 8; ++s) { e[s] = z[s] + z[16 - s]; o[s] = z[s] - z[16 - s]; }
#pragma unroll
    for (int k = 0; k <= 8; ++k) { float a = (k & 1) ? z[0] - z[8] : z[0] + z[8];
#pragma unroll
        for (int s = 1; s < 8; ++s) a += C16[(k * s) & 15] * e[s];
        r[k] = a; }
#pragma unroll
    for (int k = 1; k < 8; ++k) { float a = 0.f;
#pragma unroll
        for (int s = 1; s < 8; ++s) a -= C16[(k * s + 12) & 15] * o[s];
        r[8 + k] = a; }
}
__device__ __forceinline__ void p2_dft16(Frame& F, int di) {
    const int it = di * 512 + F.tid, cv = it & 63, s_lo = (it >> 6) & 127, b = it >> 13;
#pragma unroll 1
    for (int hf = 0; hf < 2; ++hf) {
        const bf16* zp = F.Z + ((size_t)(b * 2048 + s_lo)) * 512 + 8 * cv + 4 * hf;
        u32x2 in[16];
#pragma unroll
        for (int s = 0; s < 16; ++s) in[s] = *(const u32x2*)(zp + (size_t)s * 128 * 512);
        u32x2 outp[16];
#pragma unroll
        for (int jp = 0; jp < 2; ++jp) {
            float zl[16], zh[16], rl[16], rh[16];
#pragma unroll
            for (int s = 0; s < 16; ++s) { zl[s] = bflo(in[s][jp]); zh[s] = bfhi(in[s][jp]); }
            dft16(zl, rl); dft16(zh, rh);
#pragma unroll
            for (int pl = 0; pl < 16; ++pl) outp[pl][jp] = pk_bf16(rl[pl], rh[pl]);
        }
        bf16* xp = F.X1 + ((size_t)(b * 16) * 128 + s_lo) * 512 + 8 * cv + 4 * hf;
#pragma unroll
        for (int pl = 0; pl < 16; ++pl) *(u32x2*)(xp + (size_t)pl * 128 * 512) = outp[pl];
    }
}
__device__ __forceinline__ v4u pack8(const f32x16& x, int s) { v4u p; p.x = pk_bf16(x[8 * s], x[8 * s + 1]); p.y = pk_bf16(x[8 * s + 2], x[8 * s + 3]); p.z = pk_bf16(x[8 * s + 4], x[8 * s + 5]); p.w = pk_bf16(x[8 * s + 6], x[8 * s + 7]); return p; }
__device__ __forceinline__ void p3_unit_decode(int ui, int& b, int& k1) { b = ui >> 4; const int j = ui & 15; k1 = j < 8 ? j : (j == 8 ? 8 : 24 - j); }
__device__ __forceinline__ void p2_mtf(Frame& F) {
    const int gt = (F.vcu * NWAVES + F.wave) * 64 + F.lane, NT = F.G * NWAVES * 64;
    for (int i = gt; i < 4 * 2 * 4 * 16 * 64; i += NT) { const int ln = i & 63, ks = (i >> 6) & 15, et = (i >> 10) & 3, c = (i >> 12) & 1, g = i >> 13;
        *(v4u*)(F.MTF + (size_t)i * 8) = *(const v4u*)(F.MT + ((size_t)(g * 256 + c * 128 + et * 32 + (ln & 31))) * 256 + 16 * ks + 8 * (ln >> 5)); }
}
__device__ __forceinline__ void p3_slab_load(Frame& F, int b, int k1, int g, v4u (&pf)[8]) {
    const int k1p = k1 <= 8 ? k1 : 16 - k1; const bool has_im = (k1p != 0 && k1p != 8);
    const bf16* xr = F.X1 + ((size_t)(b * 16 + k1p) * 128) * 512 + g * 128; const bf16* xi = has_im ? F.X1 + ((size_t)(b * 16 + 8 + k1p) * 128) * 512 + g * 128 : xr;
    const unsigned fl = k1 > 8 ? 0x80008000u : 0u;
#pragma unroll
    for (int i = 0; i < 8; ++i) { const int cidx = i * 512 + F.tid, row = cidx >> 5, chunk = cidx & 31; const bool im = chunk >= 16;
        v4u t = *(const v4u*)((im ? xi : xr) + (size_t)row * 512 + (chunk & 15) * 8);
        const unsigned x = im ? fl : 0u, m = (im && !has_im) ? 0u : 0xffffffffu;
        t.x = (t.x ^ x) & m; t.y = (t.y ^ x) & m; t.z = (t.z ^ x) & m; t.w = (t.w ^ x) & m; pf[i] = t; }
}
__device__ __forceinline__ void p3_slab_store(LAS unsigned char* slab, const v4u (&pf)[8], int tid) {
#pragma unroll
    for (int i = 0; i < 8; ++i) { const int cidx = i * 512 + tid, row = cidx >> 5, chunk = cidx & 31; *(LAS v4u*)(slab + row * 512 + ((chunk ^ (row & 15)) << 4)) = pf[i]; }
}
__device__ __forceinline__ void p3_fourier_all(Frame& F) {
    LAS unsigned char* slab = F.lds; LAS unsigned char* xb = F.lds + 65536;
    const int tid = F.tid, lane = F.lane, w = F.wave, r = lane & 31, hh = lane >> 5;
    const int et1 = w & 3, c1 = w >> 2;
    const int kt2 = w & 3, eh2 = w >> 2;
    v4u pf[8];
    bool first = true;
#pragma unroll 1
    for (int ui = blockIdx.x; ui < 512; ui += F.G) {
        int b, k1; p3_unit_decode(ui, b, k1);
        const int k1p = k1 <= 8 ? k1 : 16 - k1; const bool has_im = (k1p != 0 && k1p != 8);
        bf16x8 Ef[16], bmA[4], bmB[4];
#pragma unroll
        for (int scs = 0; scs < 16; ++scs) Ef[scs] = *(const bf16x8*)(F.ECS + ((((size_t)k1 * 4 + kt2) * 16 + scs) * 64 + lane) * 8);
#define P3_LDBM(dst, gg, k0) do { _Pragma("unroll") for (int q_ = 0; q_ < 4; ++q_) dst[q_] = *(const bf16x8*)(F.MTF + ((((size_t)(gg) * 2 + c1) * 4 + et1) * 16 + (k0) + q_) * 512 + lane * 8); } while (0)
#define P3_MMA4(src, k0) do { _Pragma("unroll") for (int q_ = 0; q_ < 4; ++q_) { _Pragma("unroll") for (int st = 0; st < 4; ++st) { const int row = 32 * st + r; \
            const bf16x8 ax = *(const LAS bf16x8*)(slab + row * 512 + (((2 * ((k0) + q_) + hh) ^ (row & 15)) << 4)); Dt[st] = __builtin_amdgcn_mfma_f32_32x32x16_bf16(ax, src[q_], Dt[st], 0, 0, 0); } } } while (0)
        P3_LDBM(bmA, 0, 0);
        if (first) { p3_slab_load(F, b, k1, 0, pf); p3_slab_store(slab, pf, tid); __syncthreads(); first = false; }
        const int k2 = 32 * kt2 + r; const size_t tok = (size_t)b * 2048 + k1 + 16 * k2;
#pragma unroll 1
        for (int g = 0; g < 4; ++g) {
            f32x16 Dt[4];
#pragma unroll
            for (int a = 0; a < 4; ++a)
#pragma unroll
                for (int i = 0; i < 16; ++i) Dt[a][i] = 0.f;
            P3_LDBM(bmB, g, 4);
            const int nhalf = has_im ? 2 : 1;
#pragma unroll 1
            for (int half = 0; half < nhalf; ++half) {
                const int k0 = 8 * half; const bool more = half + 1 < nhalf;
                P3_MMA4(bmA, k0);
                if (more) P3_LDBM(bmA, g, k0 + 8);
                P3_MMA4(bmB, k0 + 4);
                if (more) P3_LDBM(bmB, g, k0 + 12);
            }
#pragma unroll
            for (int st = 0; st < 4; ++st)
#pragma unroll
                for (int s = 0; s < 2; ++s) *(LAS v4u*)(xb + ((((st * 2 + c1) * 2 + s) * 4 + et1) << 10) + lane * 16) = pack8(Dt[st], s);
            const bool nxt_unit = (g == 3), has_next = !nxt_unit || (ui + F.G < 512);
            if (has_next) { int nb = b, nk1 = k1; if (nxt_unit) p3_unit_decode(ui + F.G, nb, nk1); p3_slab_load(F, nb, nk1, nxt_unit ? 0 : g + 1, pf); }
            __syncthreads();
            if (g < 3) P3_LDBM(bmA, g + 1, 0);
            f32x16 Yt[2];
#pragma unroll
            for (int a = 0; a < 2; ++a)
#pragma unroll
                for (int i = 0; i < 16; ++i) Yt[a][i] = 0.f;
#pragma unroll
            for (int scs = 0; scs < 16; ++scs)
#pragma unroll
                for (int eti = 0; eti < 2; ++eti) { const bf16x8 df = *(const LAS bf16x8*)(xb + ((scs * 4 + 2 * eh2 + eti) << 10) + lane * 16);
                    Yt[eti] = __builtin_amdgcn_mfma_f32_32x32x16_bf16(df, Ef[scs], Yt[eti], 0, 0, 0); }
#pragma unroll
            for (int eti = 0; eti < 2; ++eti)
#pragma unroll
                for (int qd = 0; qd < 4; ++qd) { const int e0 = g * 128 + (2 * eh2 + eti) * 32 + 8 * qd + 4 * hh; const f32x4 bias = *(const f32x4*)(F.b_f + e0); const u32x2 sgv = *(const u32x2*)(F.SGB + tok * 512 + e0);
                    u32x2 o; o.x = pk_bf16((Yt[eti][4 * qd + 0] + bias[0]) * bflo(sgv.x), (Yt[eti][4 * qd + 1] + bias[1]) * bfhi(sgv.x)); o.y = pk_bf16((Yt[eti][4 * qd + 2] + bias[2]) * bflo(sgv.y), (Yt[eti][4 * qd + 3] + bias[3]) * bfhi(sgv.y));
                    *(u32x2*)(F.A2 + tok * 1024 + 512 + e0) = o; }
            if (has_next) p3_slab_store(slab, pf, tid);
            __syncthreads();
        }
    }
}
__device__ __forceinline__ void p5_final_rows(Frame& F, int row0, int nrows) {
    const int lane = F.lane;
    f32x4 pg[4];
#pragma unroll
    for (int j = 0; j < 4; ++j) pg[j] = *(const f32x4*)(F.post_g + 4 * lane + 256 * j);
    for (int mb = row0 + 4 * F.wave; mb < row0 + nrows; mb += 4 * NWAVES) {
        float qv = F.YSQ[(size_t)mb * 16 + lane];
        u32x2 y[4][4]; f32x4 xv[4][4];
#pragma unroll
        for (int i = 0; i < 4; ++i) {
#pragma unroll
            for (int j = 0; j < 4; ++j) { y[i][j] = *(const u32x2*)(F.Y + (size_t)(mb + i) * D + 4 * lane + 256 * j); xv[i][j] = *(const f32x4*)(F.x + (size_t)(mb + i) * D + 4 * lane + 256 * j); } }
        qv += __shfl_xor(qv, 1); qv += __shfl_xor(qv, 2); qv += __shfl_xor(qv, 4); qv += __shfl_xor(qv, 8);
#pragma unroll
        for (int i = 0; i < 4; ++i) {
            const float rstd = rsqrtf(__shfl(qv, 16 * i) * (1.f / D) + EPS);
#pragma unroll
            for (int j = 0; j < 4; ++j) { const unsigned w0 = y[i][j].x, w1 = y[i][j].y;
                f32x4 o; o.x = xv[i][j].x + bflo(w0) * rstd * pg[j].x; o.y = xv[i][j].y + bfhi(w0) * rstd * pg[j].y; o.z = xv[i][j].z + bflo(w1) * rstd * pg[j].z; o.w = xv[i][j].w + bfhi(w1) * rstd * pg[j].w;
                *(f32x4*)(F.out + (size_t)(mb + i) * D + 4 * lane + 256 * j) = o; }
        }
    }
}

struct Args { const float* in[11]; float* out; unsigned char* ws; int ph_lo, ph_hi, li, pad; };
__global__ void __launch_bounds__(NWAVES * 64, 2) mega_fwd(Args args) {
    extern __shared__ __attribute__((aligned(16))) unsigned char lds[];
    Frame F;
    F.lds = (LAS unsigned char*)lds;
    F.MISC = (volatile LAS unsigned*)(F.lds + MISC_OFF);
    F.tid = threadIdx.x; F.lane = F.tid & 63; F.wave = __builtin_amdgcn_readfirstlane(F.tid >> 6);
    F.G = gridDim.x; { const int bx = blockIdx.x; F.vcu = (F.G % 8 == 0) ? (bx % 8) * (F.G / 8) + bx / 8 : bx; }
    unsigned char* ws = args.ws;
    F.ctl = (gu32*)(ws + WS_CTL);
    F.x = args.in[0]; F.pre_g = args.in[1]; F.post_g = args.in[2]; F.w_in = args.in[3]; F.ln_g = args.in[4]; F.ln_b = args.in[5]; F.w_s = args.in[6]; F.b_s = args.in[7];
    F.w_f = args.in[8]; F.b_f = args.in[9]; F.w_out = args.in[10]; F.out = args.out;
    F.WIN = (bf16*)(ws + WS_WIN); F.WOUT = (bf16*)(ws + WS_WOUT); F.WSB = (bf16*)(ws + WS_WSB); F.MT = (bf16*)(ws + WS_MT); F.MTF = (bf16*)(ws + WS_MTF); F.ECS = (bf16*)(ws + WS_ECS);
    F.H = (bf16*)(ws + WS_H); F.UG = (bf16*)(ws + WS_UG); F.GV = (bf16*)(ws + WS_GV); F.Z = (bf16*)(ws + WS_Z); F.SGB = (bf16*)(ws + WS_SGB); F.X1 = (bf16*)(ws + WS_X1);
    F.A2 = (bf16*)(ws + WS_A2); F.Y = (bf16*)(ws + WS_Y); F.VSTP = (float*)(ws + WS_VSTP); F.YSQ = (float*)(ws + WS_YSQ);
    for (int u = F.tid; u < (LDS_BYTES - LDSCTL_OFF) / 4; u += NWAVES * 64) ((LAS unsigned*)(F.lds + LDSCTL_OFF))[u] = 0u;
    __syncthreads();
    XcdBarrier bar; bar.bar = (unsigned*)(F.ctl + CW_BAR); bar.x = 0; bar.st = nullptr;
    if (N_LAUNCHES != PER_PHASE) bar = xcd_barrier_post((unsigned*)(F.ctl + CW_BAR), F.MISC + 8);
#define GRID_BAR() do { if (N_LAUNCHES != PER_PHASE) xcd_barrier(bar); } while (0)
    const int lo = args.ph_lo, hi = args.ph_hi;
#define IN(k) (lo <= (k) && (k) < hi)
#define BOTH(k) (IN(k) && IN((k) + 1))
    if (IN(0)) { p0_prologue(F); if (BOTH(0)) GRID_BAR(); }
    if (IN(1)) {
        pg8::Gemm g{F.H, F.WIN, M, DIN, D}; pg8::StaticOrder S; S.init(M, DIN, F.G, (int)blockIdx.x);
        pg8::EpiIn E{F.UG, F.GV, F.Z, F.SGB, F.VSTP};
        pg8::gemm_phase<pg8::EpiIn, pg8::StaticOrder, true, true>(F.lds + RING_OFF, g, S, E);
        if (BOTH(1)) GRID_BAR();
    }
    if (IN(2)) {
        p2_mtf(F);
        for (int i = blockIdx.x; i < 1024; i += F.G) { if (i < 512) p2_spatial(F, i); else p2_dft16(F, i - 512); }
        if (BOTH(2)) GRID_BAR();
    }
    if (IN(3)) {
        p3_fourier_all(F);
        if (BOTH(3)) GRID_BAR();
    }
    if (IN(4)) {
        pg8::Gemm g{F.A2, F.WOUT, M, D, D}; pg8::PanelOrder S{F.G, F.vcu, M / 256, D / 256};
        pg8::EpiY E{F.Y, F.YSQ};
        pg8::gemm_phase<pg8::EpiY, pg8::PanelOrder, true, true>(F.lds + RING_OFF, g, S, E);
        __builtin_amdgcn_fence(__ATOMIC_ACQUIRE, "agent");
        for (int pm = F.vcu; pm < M / 256; pm += F.G) p5_final_rows(F, pm * 256, 256);
    }
#undef IN
#undef BOTH
}

extern "C" void kernel_launch(void* const* d_in, const int* in_sizes, int n_in, void* d_out, int out_size, void* d_ws, size_t ws_size, hipStream_t stream) {
    static int grid = 0;
    if (grid == 0) {
        if (n_in != 11 || in_sizes[0] != M * D || out_size != M * D || ws_size < WS_END) { fprintf(stderr, "kernel_launch: unexpected shapes / workspace (n_in %d, in0 %d, out %d, ws %zu)\n", n_in, n_in > 0 ? in_sizes[0] : -1, out_size, ws_size); grid = -1; return; }
        int dev = 0, cus = 0, per_cu = 0;
        if (hipGetDevice(&dev) != hipSuccess || hipDeviceGetAttribute(&cus, hipDeviceAttributeMultiprocessorCount, dev) != hipSuccess) { grid = -1; return; }
        if (hipFuncSetAttribute((const void*)mega_fwd, hipFuncAttributeMaxDynamicSharedMemorySize, LDS_BYTES) != hipSuccess) { fprintf(stderr, "kernel_launch: hipFuncSetAttribute failed\n"); grid = -1; return; }
        if (hipOccupancyMaxActiveBlocksPerMultiprocessor(&per_cu, (const void*)mega_fwd, NWAVES * 64, LDS_BYTES) != hipSuccess || per_cu < 1) { fprintf(stderr, "kernel_launch: occupancy query says %d blocks per CU\n", per_cu); (void)hipGetLastError(); per_cu = 1; }
        grid = cus;
    }
    if (grid < 0) return;
    (void)hipMemsetAsync((char*)d_ws + WS_CTL, 0, CTL_ZERO_BYTES, stream);
    Args a; memset(&a, 0, sizeof(a));
    for (int i = 0; i < 11; ++i) a.in[i] = (const float*)d_in[i];
    a.out = (float*)d_out; a.ws = (unsigned char*)d_ws;
    for (int li = 0; li < N_LAUNCHES; ++li) {
        a.ph_lo = (N_LAUNCHES == PER_PHASE) ? li : 0; a.ph_hi = (N_LAUNCHES == PER_PHASE) ? li + 1 : PER_PHASE; a.li = li;
        hipLaunchKernelGGL(mega_fwd, dim3(grid), dim3(NWAVES * 64), LDS_BYTES, stream, a);
    }
    if (PROBE_REPEAT >= 0) { a.ph_lo = PROBE_REPEAT; a.ph_hi = PROBE_REPEAT + 1; a.li = 1; hipLaunchKernelGGL(mega_fwd, dim3(grid), dim3(NWAVES * 64), LDS_BYTES, stream, a); }
}
```

```cpp
#include <hip/hip_runtime.h>
#include <cstdio>
#include <cstdint>
#include <cstring>

namespace pg8 {
#define PG8_LAS __attribute__((address_space(3)))
typedef unsigned short bf16_t;
typedef short bf16x8 __attribute__((ext_vector_type(8)));
typedef float f32x4 __attribute__((ext_vector_type(4)));
typedef unsigned u32x4 __attribute__((ext_vector_type(4)));
constexpr int BM = 256, BK = 64, HALF = 128, HTB = HALF * BK * 2  , STAGE_BYTES = 8 * HTB, NXCD = 8, WGM = 8;

__host__ __device__ __forceinline__ int lds_byte(int r, int c) { const int st = (r >> 4) * 2 + (c >> 5), rr = r & 15, cc = c & 31, ob = rr * 64 + cc * 2; return st * 1024 + (ob ^ (((ob >> 9) & 1) << 5)); }
__host__ __device__ __forceinline__ void stage_rc(int b, int& R, int& C) { const int st = b / 1024, sb = b % 1024, swz = sb ^ (((sb >> 9) & 1) << 5); R = (st >> 1) * 16 + swz / 64; C = (st & 1) * 32 + (swz % 64) / 2; }
__host__ __device__ __forceinline__ int perm32(int rho) { const int n = rho >> 4, i = rho & 15; return 8 * (i >> 2) + 4 * n + (i & 3); }

struct Unit { int pm, pn; };
struct Gemm { const bf16_t* A; const bf16_t* Bt; int M, N, K; };

struct StaticOrder {
    int nM, nN, nwg, G, c;
    __host__ __device__ void init(int M, int N, int G_, int c_) { nM = M / BM; nN = N / BM; nwg = nM * nN; G = G_; c = c_; }
    __host__ __device__ bool next(int i, Unit& u) const {
        const long L = (long)i * G + c; if (L >= nwg) return false;
        int wgid = (int)L; { const int q = nwg / NXCD, r = nwg % NXCD, xcd = wgid % NXCD, off = wgid / NXCD; wgid = (xcd < r ? xcd * (q + 1) : r * (q + 1) + (xcd - r) * q) + off; }
        const int nig = WGM * nN, gid = wgid / nig, fm = gid * WGM, gsz = (nM - fm) < WGM ? (nM - fm) : WGM;
        u.pm = fm + ((wgid % nig) % gsz); u.pn = (wgid % nig) / gsz; return true;
    }
    __device__ __forceinline__ void a_ready(const Unit&) const {}
    __device__ __forceinline__ void done(const Unit&) const {}
};

typedef float f32x2 __attribute__((ext_vector_type(2)));
__device__ __forceinline__ f32x2 gelu_pk(f32x2 v) {
    const f32x2 av = __builtin_elementwise_abs(v), d = av * 0.2316418882f + 1.0f;
    f32x2 t; t.x = __builtin_amdgcn_rcpf(d.x); t.y = __builtin_amdgcn_rcpf(d.y);
    f32x2 q = t * 0.5307027145f + (-0.7265760135f); q = q * t + 0.7107068705f; q = q * t + (-0.142248368f); q = q * t + 0.127414796f; q = q * t;
    const f32x2 s = (v * v) * (-0.72134752044f);
    f32x2 e; e.x = __builtin_amdgcn_exp2f(s.x); e.y = __builtin_amdgcn_exp2f(s.y);
    const f32x2 m = v * (q * e), r = v - m;
    f32x2 o; o.x = v.x < 0.f ? m.x : r.x; o.y = v.y < 0.f ? m.y : r.y; return o;
}
typedef __bf16 bf16x2_t __attribute__((ext_vector_type(2)));
__device__ __forceinline__ unsigned pk_bf16(float lo, float hi) { const f32x2 f = {lo, hi}; return __builtin_bit_cast(unsigned, __builtin_convertvector(f, bf16x2_t)); }
__device__ __forceinline__ float silu_f(float v) { return v * __builtin_amdgcn_rcpf(1.0f + __builtin_amdgcn_exp2f(-1.44269504089f * v)); }
struct EpiIn {
    static constexpr bool PERM = true, AFTER_DRAIN = false;
    bf16_t *UG, *GV, *Z, *SGB; float* VSTP;
    __device__ __forceinline__ void operator()(const f32x4 (&acc)[2][2][4][2], const Unit& u, int wr, int wc, int fr, int fq) const {
        const int row0 = u.pm * BM + wr * 64 + fr, cl = wc * 32 + 8 * fq;
        if (u.pn < 4) {
            bf16_t* base = UG + (size_t)row0 * 512 + u.pn * 128 + cl;
#pragma unroll
            for (int ai = 0; ai < 2; ++ai)
#pragma unroll
                for (int m = 0; m < 4; ++m) {
                    const f32x4 a0 = acc[ai][0][m][0], a1 = acc[ai][0][m][1], g0 = acc[ai][1][m][0], g1 = acc[ai][1][m][1];
                    const f32x2 p0 = gelu_pk((f32x2){a0[0], a0[1]}), p1 = gelu_pk((f32x2){a0[2], a0[3]}), p2 = gelu_pk((f32x2){a1[0], a1[1]}), p3 = gelu_pk((f32x2){a1[2], a1[3]});
                    u32x4 w;
                    w.x = pk_bf16(p0.x * silu_f(g0[0]), p0.y * silu_f(g0[1])); w.y = pk_bf16(p1.x * silu_f(g0[2]), p1.y * silu_f(g0[3]));
                    w.z = pk_bf16(p2.x * silu_f(g1[0]), p2.y * silu_f(g1[1])); w.w = pk_bf16(p3.x * silu_f(g1[2]), p3.y * silu_f(g1[3]));
                    *(u32x4*)(base + (size_t)(ai * HALF + m * 16) * 512) = w;
                }
        } else if (u.pn < 6) {
            bf16_t* base = GV + (size_t)row0 * 512 + (u.pn - 4) * 256 + cl;
            float* sp = VSTP + (size_t)row0 * 16 + ((u.pn - 4) * 4 + wc) * 2;
#pragma unroll
            for (int ai = 0; ai < 2; ++ai)
#pragma unroll
                for (int m = 0; m < 4; ++m) {
                    float s = 0.f, q = 0.f;
#pragma unroll
                    for (int bj = 0; bj < 2; ++bj) {
                        const f32x4 a0 = acc[ai][bj][m][0], a1 = acc[ai][bj][m][1];
                        const f32x2 p0 = gelu_pk((f32x2){a0[0], a0[1]}), p1 = gelu_pk((f32x2){a0[2], a0[3]}), p2 = gelu_pk((f32x2){a1[0], a1[1]}), p3 = gelu_pk((f32x2){a1[2], a1[3]});
                        s += ((p0.x + p0.y) + (p1.x + p1.y)) + ((p2.x + p2.y) + (p3.x + p3.y));
                        q += ((p0.x * p0.x + p0.y * p0.y) + (p1.x * p1.x + p1.y * p1.y)) + ((p2.x * p2.x + p2.y * p2.y) + (p3.x * p3.x + p3.y * p3.y));
                        u32x4 w; w.x = pk_bf16(p0.x, p0.y); w.y = pk_bf16(p1.x, p1.y); w.z = pk_bf16(p2.x, p2.y); w.w = pk_bf16(p3.x, p3.y);
                        *(u32x4*)(base + (size_t)(ai * HALF + m * 16) * 512 + bj * HALF) = w;
                    }
                    s += __shfl_xor(s, 16); s += __shfl_xor(s, 32); q += __shfl_xor(q, 16); q += __shfl_xor(q, 32);
                    if (fq == 0) *(f32x2*)(sp + (size_t)(ai * HALF + m * 16) * 16) = (f32x2){s, q};
                }
        } else {
            const bool act = u.pn >= 8;
            bf16_t* base = (act ? SGB + (size_t)(u.pn - 8) * 256 : Z + (size_t)(u.pn - 6) * 256) + (size_t)row0 * 512 + cl;
#pragma unroll
            for (int ai = 0; ai < 2; ++ai)
#pragma unroll
                for (int m = 0; m < 4; ++m)
#pragma unroll
                    for (int bj = 0; bj < 2; ++bj) {
                        f32x4 a0 = acc[ai][bj][m][0], a1 = acc[ai][bj][m][1];
                        if (act) { a0 = (f32x4){silu_f(a0[0]), silu_f(a0[1]), silu_f(a0[2]), silu_f(a0[3])}; a1 = (f32x4){silu_f(a1[0]), silu_f(a1[1]), silu_f(a1[2]), silu_f(a1[3])}; }
                        u32x4 w; w.x = pk_bf16(a0[0], a0[1]); w.y = pk_bf16(a0[2], a0[3]); w.z = pk_bf16(a1[0], a1[1]); w.w = pk_bf16(a1[2], a1[3]);
                        *(u32x4*)(base + (size_t)(ai * HALF + m * 16) * 512 + bj * HALF) = w;
                    }
        }
    }
};
struct EpiY {
    static constexpr bool PERM = true, AFTER_DRAIN = false;
    bf16_t* Y; float* YSQ;
    __device__ __forceinline__ void operator()(const f32x4 (&acc)[2][2][4][2], const Unit& u, int wr, int wc, int fr, int fq) const {
        const int row0 = u.pm * BM + wr * 64 + fr, cl = wc * 32 + 8 * fq;
        bf16_t* base = Y + (size_t)row0 * 1024 + u.pn * 256 + cl;
        float* sp = YSQ + (size_t)row0 * 16 + u.pn * 4 + wc;
#pragma unroll
        for (int ai = 0; ai < 2; ++ai)
#pragma unroll
            for (int m = 0; m < 4; ++m) {
                float q = 0.f;
#pragma unroll
                for (int bj = 0; bj < 2; ++bj) {
                    const f32x4 a0 = acc[ai][bj][m][0], a1 = acc[ai][bj][m][1];
                    q += ((a0[0] * a0[0] + a0[1] * a0[1]) + (a0[2] * a0[2] + a0[3] * a0[3])) + ((a1[0] * a1[0] + a1[1] * a1[1]) + (a1[2] * a1[2] + a1[3] * a1[3]));
                    u32x4 w; w.x = pk_bf16(a0[0], a0[1]); w.y = pk_bf16(a0[2], a0[3]); w.z = pk_bf16(a1[0], a1[1]); w.w = pk_bf16(a1[2], a1[3]);
                    *(u32x4*)(base + (size_t)(ai * HALF + m * 16) * 1024 + bj * HALF) = w;
                }
                q += __shfl_xor(q, 16); q += __shfl_xor(q, 32);
                if (fq == 0) sp[(size_t)(ai * HALF + m * 16) * 16] = q;
            }
    }
};
struct PanelOrder {
    int G, c, nM, nN;
    __device__ __forceinline__ bool next(int i, Unit& u) const { const int pm = c + G * (i / nN); if (pm >= nM) return false; u.pm = pm; u.pn = i % nN; return true; }
    __device__ __forceinline__ void a_ready(const Unit&) const {}
    __device__ __forceinline__ void done(const Unit&) const {}
};


template <class Epi, class Sched, bool ALIGN_EPI = false, bool SP2 = false>
__device__ __forceinline__ void gemm_phase(PG8_LAS unsigned char* lds, const Gemm g, const Sched& S, const Epi& E) {
    const int tid = threadIdx.x, wid = __builtin_amdgcn_readfirstlane(tid >> 6), lane = tid & 63, wr = wid >> 2, wc = wid & 3, fr = lane & 15, fq = lane >> 4;
    const int K = g.K, nt = K / BK;
    unsigned voffA[2], voffB[2];
#pragma unroll
    for (int i = 0; i < 2; ++i) { int R, C; stage_rc(tid * 16 + i * 8192, R, C); const int Rb = Epi::PERM ? ((R & ~31) + perm32(R & 31)) : R;
        voffA[i] = (unsigned)(R * K + C) * 2u; voffB[i] = (unsigned)(Rb * K + C) * 2u; }
    const size_t kstep = (size_t)(BK * 2);
    const size_t hstep = (size_t)HALF * K * 2;
    const size_t tstep = 2 * hstep;
    const unsigned ldsw = (unsigned)wid * 1024u;
    const int aoff = lds_byte(wr * 64 + fr, fq * 8), boff = lds_byte(wc * 32 + fr, fq * 8);
#define PG8_SA(b, h) (((b) * 2 + (h)) * HTB)
#define PG8_SB(b, h) ((4 + (b) * 2 + (h)) * HTB)
#define PG8_STAGE(bufoff, gbase, voff) do { _Pragma("unroll") for (int _i = 0; _i < 2; ++_i) \
        __builtin_amdgcn_global_load_lds((const unsigned*)((const char*)(gbase) + (voff)[_i]), (PG8_LAS unsigned*)(lds + (bufoff) + ldsw + _i * 8192), 16, 0, 0); } while (0)
#define PG8_LDA(dst, b, h) do { _Pragma("unroll") for (int m = 0; m < 4; ++m) _Pragma("unroll") for (int k = 0; k < 2; ++k) dst[m][k] = *(const PG8_LAS bf16x8*)(lds + PG8_SA(b, h) + aoff + m * 2048 + k * 1024); } while (0)
#define PG8_LDB(dst, b, h) do { _Pragma("unroll") for (int n = 0; n < 2; ++n) _Pragma("unroll") for (int k = 0; k < 2; ++k) dst[n][k] = *(const PG8_LAS bf16x8*)(lds + PG8_SB(b, h) + boff + n * 2048 + k * 1024); } while (0)
#define PG8_MMA(ai, bj, At, Bt) do { __builtin_amdgcn_s_setprio(1); _Pragma("unroll") for (int m = 0; m < 4; ++m) _Pragma("unroll") for (int n = 0; n < 2; ++n) _Pragma("unroll") for (int k = 0; k < 2; ++k) \
        acc[ai][bj][m][n] = __builtin_amdgcn_mfma_f32_16x16x32_bf16(Bt[n][k], At[m][k], acc[ai][bj][m][n], 0, 0, 0); __builtin_amdgcn_s_setprio(0); } while (0)
#define PG8_WAIT_V(n) asm volatile("s_waitcnt vmcnt(" #n ")" ::: "memory")
#define PG8_WAIT_L(n) asm volatile("s_waitcnt lgkmcnt(" #n ")" ::: "memory")
#define PG8_BAR __builtin_amdgcn_s_barrier()
#define PG8_SCHED __builtin_amdgcn_sched_barrier(0)
    Unit cur, nxt; int ui = 0;
    if (!S.next(0, cur)) return;
    f32x4 acc[2][2][4][2];
#pragma unroll
    for (int a = 0; a < 2; ++a)
#pragma unroll
        for (int b = 0; b < 2; ++b)
#pragma unroll
            for (int m = 0; m < 4; ++m)
#pragma unroll
                for (int n = 0; n < 2; ++n) acc[a][b][m][n] = (f32x4){0.f, 0.f, 0.f, 0.f};
    bf16x8 At[4][2], B0[2][2], B1[2][2];
    const char* cA = (const char*)g.A + (size_t)cur.pm * tstep; const char* cB = (const char*)g.Bt + (size_t)cur.pn * tstep;
    S.a_ready(cur);
    if constexpr (SP2) {
        PG8_STAGE(PG8_SB(0, 0), cB, voffB); PG8_STAGE(PG8_SB(0, 1), cB + hstep, voffB); PG8_STAGE(PG8_SA(0, 0), cA, voffA); PG8_STAGE(PG8_SA(0, 1), cA + hstep, voffA);
        if (wr == 1) PG8_BAR;
        PG8_WAIT_V(2); PG8_BAR;
        PG8_STAGE(PG8_SB(1, 0), cB + kstep, voffB); PG8_STAGE(PG8_SA(1, 0), cA + kstep, voffA); PG8_STAGE(PG8_SB(1, 1), cB + hstep + kstep, voffB);
        PG8_WAIT_V(6); PG8_BAR;
    } else {
        PG8_STAGE(PG8_SB(0, 0), cB, voffB); PG8_STAGE(PG8_SA(0, 0), cA, voffA); PG8_STAGE(PG8_SB(0, 1), cB + hstep, voffB); PG8_STAGE(PG8_SA(0, 1), cA + hstep, voffA);
        if (wr == 1) PG8_BAR;
        PG8_WAIT_V(4); PG8_BAR;
        PG8_STAGE(PG8_SB(1, 0), cB + kstep, voffB); PG8_STAGE(PG8_SA(1, 0), cA + kstep, voffA); PG8_STAGE(PG8_SB(1, 1), cB + hstep + kstep, voffB);
        PG8_WAIT_V(6); PG8_BAR;
    }
    for (;;) {
        const bool has_next = S.next(ui + 1, nxt);
        const char* nA = has_next ? (const char*)g.A + (size_t)nxt.pm * tstep : cA; const char* nB = has_next ? (const char*)g.Bt + (size_t)nxt.pn * tstep : cB;
        for (int t = 0; t < nt; t += 2) {
            const bool last = (t == nt - 2);
            const char* a1 = cA + (size_t)(t + 1) * kstep;
            const char* a2 = last ? nA : cA + (size_t)(t + 2) * kstep; const char* b2 = last ? nB : cB + (size_t)(t + 2) * kstep;
            const char* a3 = a2 + kstep; const char* b3 = b2 + kstep;
            if (last && has_next) S.a_ready(nxt);
            if constexpr (SP2) {
            PG8_LDB(B0, 0, 0); PG8_LDB(B1, 0, 1); PG8_SCHED; PG8_LDA(At, 0, 0); PG8_STAGE(PG8_SA(1, 1), a1 + hstep, voffA);
            PG8_WAIT_V(8); PG8_WAIT_L(0); PG8_BAR; PG8_MMA(0, 0, At, B0); PG8_MMA(0, 1, At, B1); PG8_BAR; PG8_SCHED;
            PG8_LDA(At, 0, 1); PG8_STAGE(PG8_SB(0, 0), b2, voffB); PG8_STAGE(PG8_SB(0, 1), b2 + hstep, voffB); PG8_STAGE(PG8_SA(0, 0), a2, voffA);
            PG8_WAIT_V(8); PG8_WAIT_L(0); PG8_BAR; PG8_MMA(1, 0, At, B0); PG8_MMA(1, 1, At, B1); PG8_BAR; PG8_SCHED;
            PG8_LDB(B0, 1, 0); PG8_LDB(B1, 1, 1); PG8_SCHED; PG8_LDA(At, 1, 0); PG8_STAGE(PG8_SA(0, 1), a2 + hstep, voffA);
            PG8_WAIT_V(8); PG8_WAIT_L(0); PG8_BAR; PG8_MMA(0, 0, At, B0); PG8_MMA(0, 1, At, B1); PG8_BAR; PG8_SCHED;
            PG8_LDA(At, 1, 1); PG8_STAGE(PG8_SB(1, 0), b3, voffB); PG8_STAGE(PG8_SB(1, 1), b3 + hstep, voffB); PG8_STAGE(PG8_SA(1, 0), a3, voffA);
            PG8_WAIT_V(8); PG8_WAIT_L(0); PG8_BAR; PG8_MMA(1, 0, At, B0); PG8_MMA(1, 1, At, B1); PG8_BAR; PG8_SCHED;
            } else {
            PG8_LDB(B0, 0, 0); PG8_SCHED; PG8_LDA(At, 0, 0); PG8_STAGE(PG8_SA(1, 1), a1 + hstep, voffA);
            PG8_WAIT_L(8); PG8_BAR; PG8_WAIT_L(0); PG8_MMA(0, 0, At, B0); PG8_BAR; PG8_SCHED;
            PG8_LDB(B1, 0, 1); PG8_STAGE(PG8_SB(0, 0), b2, voffB);
            PG8_BAR; PG8_WAIT_L(0); PG8_MMA(0, 1, At, B1); PG8_BAR;
            PG8_LDA(At, 0, 1); PG8_STAGE(PG8_SA(0, 0), a2, voffA);
            PG8_BAR; PG8_WAIT_L(0); PG8_MMA(1, 0, At, B0); PG8_BAR; PG8_SCHED;
            PG8_STAGE(PG8_SB(0, 1), b2 + hstep, voffB);
            PG8_WAIT_V(6); PG8_BAR; PG8_MMA(1, 1, At, B1); PG8_BAR;
            PG8_LDB(B0, 1, 0); PG8_SCHED; PG8_LDA(At, 1, 0); PG8_STAGE(PG8_SA(0, 1), a2 + hstep, voffA);
            PG8_WAIT_L(8); PG8_BAR; PG8_WAIT_L(0); PG8_MMA(0, 0, At, B0); PG8_BAR; PG8_SCHED;
            PG8_LDB(B1, 1, 1); PG8_STAGE(PG8_SB(1, 0), b3, voffB);
            PG8_BAR; PG8_WAIT_L(0); PG8_MMA(0, 1, At, B1); PG8_BAR;
            PG8_LDA(At, 1, 1); PG8_STAGE(PG8_SA(1, 0), a3, voffA);
            PG8_BAR; PG8_WAIT_L(0); PG8_MMA(1, 0, At, B0); PG8_BAR; PG8_SCHED;
            PG8_STAGE(PG8_SB(1, 1), b3 + hstep, voffB);
            PG8_WAIT_V(6); PG8_BAR; PG8_MMA(1, 1, At, B1); PG8_BAR;
            }
        }
        if constexpr (ALIGN_EPI) { if (wr == 0) PG8_BAR; }
        if constexpr (!Epi::AFTER_DRAIN) { E(acc, cur, wr, wc, fr, fq); S.done(cur); }
        if (!has_next) break;
#pragma unroll
        for (int a = 0; a < 2; ++a)
#pragma unroll
            for (int b = 0; b < 2; ++b)
#pragma unroll
                for (int m = 0; m < 4; ++m)
#pragma unroll
                    for (int n = 0; n < 2; ++n) acc[a][b][m][n] = (f32x4){0.f, 0.f, 0.f, 0.f};
        cur = nxt; cA = nA; cB = nB; ++ui;
        if constexpr (ALIGN_EPI) { if (wr == 1) PG8_BAR; }
    }
    PG8_WAIT_V(0);
    if constexpr (!ALIGN_EPI) { if (wr == 0) PG8_BAR; }
    PG8_BAR;
    if constexpr (Epi::AFTER_DRAIN) { E.fused(acc, cur, wr, wc, fr, fq, lds, wid, lane); S.done(cur); }
#undef PG8_SA
#undef PG8_SB
#undef PG8_STAGE
#undef PG8_LDA
#undef PG8_LDB
#undef PG8_MMA
#undef PG8_WAIT_V
#undef PG8_WAIT_L
#undef PG8_BAR
#undef PG8_SCHED
}
}
constexpr int NWAVES = 8;
#ifndef MK_N_LAUNCHES
#define MK_N_LAUNCHES 1
#endif
constexpr int N_LAUNCHES = MK_N_LAUNCHES;
constexpr int PER_PHASE = 5;
#ifndef PROBE_REPEAT
#define PROBE_REPEAT -1
#endif

constexpr int BATCH = 32, SEQ = 2048, D = 1024, DA = 512, DB = 512, DIN = 2560;
constexpr int M = BATCH * SEQ;
constexpr float EPS = 1e-6f;

constexpr size_t MiB = 1u << 20;
constexpr size_t WS_CTL = 0, CTL_ZERO_BYTES = 1 * MiB;
constexpr size_t WS_WIN = 2 * MiB;
constexpr size_t WS_WOUT = 8 * MiB;
constexpr size_t WS_WSB = 10 * MiB;
constexpr size_t WS_MT = 11 * MiB;
constexpr size_t WS_ECS = 12 * MiB;
constexpr size_t WS_MTF = 13 * MiB;
constexpr size_t WS_VSTP = 14 * MiB;
constexpr size_t WS_YSQ = 18 * MiB;
constexpr size_t WS_H = 32 * MiB;
constexpr size_t WS_UG = 160 * MiB;
constexpr size_t WS_GV = 224 * MiB;
constexpr size_t WS_Z = 288 * MiB;
constexpr size_t WS_SGB = 352 * MiB;
constexpr size_t WS_X1 = 416 * MiB;
constexpr size_t WS_A2 = 480 * MiB;
constexpr size_t WS_Y = 608 * MiB;
constexpr size_t WS_END = 736 * MiB;
constexpr int CW_TMO = 0, CW_CODE = 1, CW_BAR = 4096;

constexpr int RING_OFF = 0, RING_BYTES = 131072;
constexpr int LDSCTL_OFF = RING_BYTES, MISC_OFF = LDSCTL_OFF + 320;
constexpr int LDS_BYTES = 147456;
static_assert(MISC_OFF + 128 <= LDS_BYTES, "LDS map");


#define GAS __attribute__((address_space(1)))
#define LAS __attribute__((address_space(3)))
typedef unsigned short bf16;
typedef unsigned v4u __attribute__((ext_vector_type(4)));
typedef float f32x4 __attribute__((ext_vector_type(4)));
typedef short bf16x8 __attribute__((ext_vector_type(8)));
typedef GAS unsigned gu32;
typedef GAS unsigned long long gu64;
#define RLX_AGENT __ATOMIC_RELAXED, __HIP_MEMORY_SCOPE_AGENT
#define LDS_WAIT() asm volatile("s_waitcnt lgkmcnt(0)" ::: "memory")
#define VM_WAIT() asm volatile("s_waitcnt vmcnt(0)" ::: "memory")
__device__ __forceinline__ unsigned long long rt() { return __builtin_amdgcn_s_memrealtime(); }
__device__ __forceinline__ unsigned f2bf(float f) { unsigned u = __builtin_bit_cast(unsigned, f); return (u + 0x7fffu + ((u >> 16) & 1u)) >> 16; }
__device__ __forceinline__ unsigned pk2(float lo, float hi) { return f2bf(lo) | (f2bf(hi) << 16); }
#define XB_TMO      128
#define XB_XCNT(j)  (256  + 64 * (j))
#define XB_XSUB(j)  (1280 + 64 * (j))
#define XB_XGEN(j)  (2304 + 64 * (j))
#define XB_TOP      3328
#define XB_TOPGEN   3392
#define XCD_BAR_WORDS 3456
#define XB_SPIN_CAP (1u << 18)

__device__ __forceinline__ unsigned xb_ld(unsigned* p)              { return __hip_atomic_load(p, __ATOMIC_RELAXED, __HIP_MEMORY_SCOPE_AGENT); }
__device__ __forceinline__ unsigned xb_add(unsigned* p, unsigned v) { return __hip_atomic_fetch_add(p, v, __ATOMIC_RELAXED, __HIP_MEMORY_SCOPE_AGENT); }
__device__ __forceinline__ unsigned xb_xcc_id() { return (unsigned)__builtin_amdgcn_s_getreg((3 << 11) | 20) & 0xFu; }
#define XB_SPIN(cond, bar) do { unsigned _sp = 0; while (cond) { __builtin_amdgcn_s_sleep(1); \
    if ((++_sp & 255u) == 0u) { if (xb_ld(&(bar)[XB_TMO])) break; if (_sp > XB_SPIN_CAP) { atomicAdd(&(bar)[XB_TMO], 1u); break; } } } } while (0)

struct XcdBarrier {
    unsigned* bar; unsigned x;
    volatile LAS unsigned* st;
};

__device__ __forceinline__ XcdBarrier xcd_barrier_post(unsigned* bar, volatile LAS unsigned* st) {
    XcdBarrier b; b.bar = bar; b.x = xb_xcc_id(); b.st = st;
    if (threadIdx.x == 0) (void)xb_add(&bar[XB_XCNT(b.x)], 1u);
    return b;
}
__device__ __forceinline__ void xcd_barrier_complete(unsigned* bar, unsigned x, unsigned& nloc, unsigned& nx) {
    const unsigned G = gridDim.x * gridDim.y * gridDim.z;
    unsigned sum, cnt, mine, sp = 0u;
    for (;;) {
        sum = 0u; cnt = 0u; mine = 0u;
#pragma unroll
        for (unsigned j = 0; j < 16; ++j) { const unsigned c = xb_ld(&bar[XB_XCNT(j)]); sum += c; cnt += (c > 0u) ? 1u : 0u; mine = (j == x) ? c : mine; }
        if (sum == G) break;
        __builtin_amdgcn_s_sleep(1);
        if ((++sp & 255u) == 0u) { if (xb_ld(&bar[XB_TMO])) break; if (sp > XB_SPIN_CAP) { atomicAdd(&bar[XB_TMO], 1u); break; } }
    }
    nloc = mine > 0u ? mine : 1u; nx = cnt > 0u ? cnt : 1u;
}

__device__ __forceinline__ void xcd_barrier(const XcdBarrier& b) {
    asm volatile("s_waitcnt vmcnt(0)" ::: "memory");
    __syncthreads();
    if (threadIdx.x == 0) {
        unsigned* bar = b.bar;
        __builtin_amdgcn_s_waitcnt(0);
        unsigned nloc = b.st[0], nx = b.st[1];
        if (nloc == 0u) { xcd_barrier_complete(bar, b.x, nloc, nx); b.st[0] = nloc; b.st[1] = nx; }
        const unsigned old = xb_add(&bar[XB_XSUB(b.x)], 1u);
        const unsigned gen = old / nloc;
        if (old + 1u == (gen + 1u) * nloc) {
            __builtin_amdgcn_fence(__ATOMIC_RELEASE, "agent");
            asm volatile("s_waitcnt vmcnt(0)" ::: "memory");
            const unsigned og = xb_add(&bar[XB_TOP], 1u);
            const unsigned tg = og / nx;
            if (og + 1u == (tg + 1u) * nx) xb_add(&bar[XB_TOPGEN], 1u);
            else XB_SPIN(xb_ld(&bar[XB_TOPGEN]) == tg, bar);
            __builtin_amdgcn_fence(__ATOMIC_ACQUIRE, "agent");
            xb_add(&bar[XB_XGEN(b.x)], 1u);
            asm volatile("s_waitcnt vmcnt(0)" ::: "memory");
        } else {
            XB_SPIN(xb_ld(&bar[XB_XGEN(b.x)]) == gen, bar);
            __builtin_amdgcn_fence(__ATOMIC_ACQUIRE, "agent");
            asm volatile("s_waitcnt vmcnt(0)" ::: "memory");
        }
    }
    __syncthreads();
}
typedef float f32x2 __attribute__((ext_vector_type(2)));
typedef float f32x16 __attribute__((ext_vector_type(16)));
typedef unsigned u32x2 __attribute__((ext_vector_type(2)));
using pg8::pk_bf16;
struct Frame {
    LAS unsigned char* lds;
    volatile LAS unsigned* MISC;
    gu32* ctl;
    int tid, lane, wave;
    int vcu, G;
    const float *x, *pre_g, *post_g, *w_in, *ln_g, *ln_b, *w_s, *b_s, *w_f, *b_f, *w_out; float* out;
    bf16 *WIN, *WOUT, *WSB, *MT, *MTF, *ECS, *H, *UG, *GV, *Z, *SGB, *X1, *A2, *Y;
    float *VSTP, *YSQ;
};
__device__ __forceinline__ float bflo(unsigned w) { return __builtin_bit_cast(float, w << 16); }
__device__ __forceinline__ float bfhi(unsigned w) { return __builtin_bit_cast(float, w & 0xffff0000u); }
__device__ __forceinline__ float wave_sum(float v) {
#pragma unroll
    for (int o = 1; o < 64; o <<= 1) v += __shfl_xor(v, o);
    return v;
}
__device__ __forceinline__ int win_src_col(int n) { const int t = n >> 8, r = n & 255; return t < 4 ? (r < 128 ? t * 128 + r : 1024 + t * 128 + (r - 128)) : (t < 6 ? 512 + (t - 4) * 256 + r : (t < 8 ? 1536 + (t - 6) * 256 + r : 2048 + (t - 8) * 256 + r)); }
__device__ __forceinline__ void p0_transpose_item(const float* W, int K, int N, bf16* WT, const float* kscale, bool remap, LAS float* scr, int item, int lane) {
    const int nblk = N / 32, kb = item / nblk, nb = item % nblk, k0 = 64 * kb, n0 = 32 * nb, s0 = remap ? win_src_col(n0) : n0;
#pragma unroll 8
    for (int i = 0; i < 32; ++i) { const int kk = 2 * i + (lane >> 5); float v = W[(size_t)(k0 + kk) * N + s0 + (lane & 31)]; if (kscale) v *= kscale[k0 + kk]; scr[kk * 33 + (lane & 31)] = v; }
    LDS_WAIT(); asm volatile("" ::: "memory");
    const int c = lane & 7;
#pragma unroll
    for (int j = 0; j < 4; ++j) { const int n = (lane >> 3) + 8 * j; const LAS float* s = scr + (8 * c) * 33 + n;
        v4u o; o.x = pk_bf16(s[0 * 33], s[1 * 33]); o.y = pk_bf16(s[2 * 33], s[3 * 33]); o.z = pk_bf16(s[4 * 33], s[5 * 33]); o.w = pk_bf16(s[6 * 33], s[7 * 33]);
        *(GAS v4u*)(WT + (size_t)(n0 + n) * K + k0 + 8 * c) = o; }
    LDS_WAIT(); asm volatile("" ::: "memory");
}
__device__ __forceinline__ void rms_rows4_to_bf16(Frame& F, const float* xrow, bf16* orow) {
    f32x4 v[4][4]; float s[4];
#pragma unroll
    for (int i = 0; i < 4; ++i) { const GAS f32x4* xr = (const GAS f32x4*)(xrow + (size_t)i * D) + F.lane;
#pragma unroll
        for (int j = 0; j < 4; ++j) v[i][j] = xr[64 * j]; }
#pragma unroll
    for (int i = 0; i < 4; ++i) { s[i] = 0.f;
#pragma unroll
        for (int j = 0; j < 4; ++j) s[i] += (v[i][j].x * v[i][j].x + v[i][j].y * v[i][j].y) + (v[i][j].z * v[i][j].z + v[i][j].w * v[i][j].w); }
#pragma unroll
    for (int o = 1; o < 64; o <<= 1) {
#pragma unroll
        for (int i = 0; i < 4; ++i) s[i] += __shfl_xor(s[i], o); }
#pragma unroll
    for (int i = 0; i < 4; ++i) { const float r = rsqrtf(s[i] * (1.f / D) + EPS); GAS u32x2* o8 = (GAS u32x2*)(orow + (size_t)i * D) + F.lane;
#pragma unroll
        for (int j = 0; j < 4; ++j) o8[64 * j] = (u32x2){pk_bf16(v[i][j].x * r, v[i][j].y * r), pk_bf16(v[i][j].z * r, v[i][j].w * r)}; }
}
__device__ __forceinline__ void p0_prologue(Frame& F) {
    LAS float* scr = (LAS float*)(F.lds + RING_OFF + F.wave * 16384);
    const int gw = F.vcu * NWAVES + F.wave, NGW = F.G * NWAVES;
    constexpr int I_IN = (D / 64) * (DIN / 32), I_OUT = (D / 64) * (D / 32);
    for (int it = gw; it < I_IN + I_OUT; it += NGW) {
        if (it < I_IN) p0_transpose_item(F.w_in, D, DIN, F.WIN, F.pre_g, true, scr, it, F.lane);
        else p0_transpose_item(F.w_out, D, D, F.WOUT, nullptr, false, scr, it - I_IN, F.lane);
    }
    const int gt = gw * 64 + F.lane, NT = NGW * 64;
    for (int i = gt; i < 4 * 128 * 128 / 2; i += NT) { const f32x2 v = *(const f32x2*)(F.w_s + 2 * i); ((unsigned*)F.WSB)[i] = pk_bf16(v.x, v.y); }
    for (int i = gt; i < 16 * 4 * 16 * 64; i += NT) {
        const int ln = i & 63, scs = (i >> 6) & 15, kt = (i >> 10) & 3, k1 = i >> 12, k2 = 32 * kt + (ln & 31), h = ln >> 5, st = scs >> 2, c = (scs >> 1) & 1, s = scs & 1;
        float v[8];
#pragma unroll
        for (int j = 0; j < 8; ++j) { const int sl = 32 * st + 16 * s + 8 * (j >> 2) + 4 * h + (j & 3); const int idx = ((k1 + 16 * k2) * sl) & 2047; float sn, cs; sincospif((float)idx * (1.0f / 1024.0f), &sn, &cs); v[j] = c ? sn : cs; }
        v4u o; o.x = pk_bf16(v[0], v[1]); o.y = pk_bf16(v[2], v[3]); o.z = pk_bf16(v[4], v[5]); o.w = pk_bf16(v[6], v[7]);
        *(v4u*)(F.ECS + (size_t)i * 8) = o;
    }
    {   LAS float* ctab = (LAS float*)(F.lds + RING_OFF + F.wave * 16384 + 12288);
        { float sn, cs; sincospif((float)F.lane * (1.0f / 64.0f), &sn, &cs); ctab[F.lane] = cs; ctab[64 + F.lane] = -cs; }
        LDS_WAIT(); asm volatile("" ::: "memory");
        for (int i = gt; i < 4 * 128 * 128; i += NT) {
            const int c = i & 127, e = (i >> 7) & 127, g = i >> 14; float wc = 0.f, ws = 0.f; const float* wf = F.w_f + (size_t)g * 16384 + e;
#pragma unroll 8
            for (int m = 0; m < 128; ++m) { const int ph = (c * m) & 127; const float w = wf[(size_t)m * 128]; wc += ctab[ph] * w; ws += ctab[(ph + 96) & 127] * w; }
            wc *= (1.0f / 512.0f); ws *= (1.0f / 512.0f);
            unsigned short* mt = (unsigned short*)F.MT + (size_t)g * 65536;
            const unsigned pc = pk_bf16(wc, -ws);
            mt[(size_t)e * 256 + c] = (unsigned short)pc; mt[(size_t)e * 256 + 128 + c] = (unsigned short)(pk_bf16(ws, 0.f));
            mt[(size_t)(128 + e) * 256 + c] = (unsigned short)(pc >> 16); mt[(size_t)(128 + e) * 256 + 128 + c] = (unsigned short)pc;
        }
        LDS_WAIT(); asm volatile("" ::: "memory");
    }
    for (int m = 4 * gw; m < M; m += 4 * NGW) rms_rows4_to_bf16(F, F.x + (size_t)m * D, F.H + (size_t)m * D);
}

__device__ __forceinline__ int lnt_key(int c) { return ((c ^ (c >> 5)) & 1) | (((c >> 3) & 3) << 1) | (((c >> 1) & 1) << 3); }
__device__ __forceinline__ int lnt_off(int c, int qchunk) { return c * 256 + ((qchunk ^ lnt_key(c)) << 4); }
__device__ __forceinline__ void p2_spatial(Frame& F, int ci) {
    LAS unsigned char* lnt = F.lds;
    LAS float* st_mu = (LAS float*)(F.lds + 32768);
    LAS float* st_rs = st_mu + 128;
    const int m0 = ci * 128, tid = F.tid, lane = F.lane, w = F.wave;
    if (tid < 128) {
        const float* sp = F.VSTP + (size_t)(m0 + tid) * 16; float s = 0.f, q = 0.f;
#pragma unroll
        for (int i = 0; i < 8; ++i) { s += sp[2 * i]; q += sp[2 * i + 1]; }
        const float mu = s * (1.f / DA), var = fmaxf(q * (1.f / DA) - mu * mu, 0.f);
        st_mu[tid] = mu; st_rs[tid] = rsqrtf(var + EPS);
    }
    __syncthreads();
    const int cg = lane & 15, tq = lane >> 4, q0 = 16 * w + 4 * tq;
    const int fr = lane & 15, fq = lane >> 4, wcb = (w & 3) * 32, ph = (w >> 2) * 64;
    float mu4[4], rs4[4];
#pragma unroll
    for (int i = 0; i < 4; ++i) { mu4[i] = st_mu[q0 + i]; rs4[i] = st_rs[q0 + i]; }
    for (int h = 0; h < 4; ++h) {
        {
            v4u raw[4];
#pragma unroll
            for (int i = 0; i < 4; ++i) raw[i] = *(const v4u*)(F.GV + (size_t)(m0 + q0 + i) * 512 + h * 128 + 8 * cg);
            const f32x4 g0 = *(const f32x4*)(F.ln_g + h * 128 + 8 * cg), g1 = *(const f32x4*)(F.ln_g + h * 128 + 8 * cg + 4);
            const f32x4 b0 = *(const f32x4*)(F.ln_b + h * 128 + 8 * cg), b1 = *(const f32x4*)(F.ln_b + h * 128 + 8 * cg + 4);
#pragma unroll
            for (int j = 0; j < 8; ++j) {
                const float gg = j < 4 ? g0[j & 3] : g1[j & 3], bb = j < 4 ? b0[j & 3] : b1[j & 3];
                float v[4];
#pragma unroll
                for (int i = 0; i < 4; ++i) { const unsigned wd = raw[i][j >> 1]; const float xv = (j & 1) ? bfhi(wd) : bflo(wd); v[i] = (xv - mu4[i]) * rs4[i] * gg + bb; }
                const int c = 8 * cg + j;
                *(LAS u32x2*)(lnt + lnt_off(c, q0 >> 3) + (q0 & 7) * 2) = (u32x2){pk_bf16(v[0], v[1]), pk_bf16(v[2], v[3])};
            }
        }
        __syncthreads();
        f32x4 acc[2][4];
#pragma unroll
        for (int n = 0; n < 2; ++n)
#pragma unroll
            for (int t = 0; t < 4; ++t) acc[n][t] = (f32x4){0.f, 0.f, 0.f, 0.f};
#pragma unroll
        for (int ks = 0; ks < 4; ++ks) {
            bf16x8 a[2];
#pragma unroll
            for (int n = 0; n < 2; ++n) { const int c = wcb + 8 * (fr >> 2) + 4 * n + (fr & 3); a[n] = *(const LAS bf16x8*)(lnt + lnt_off(c, 4 * ks + fq)); }
#pragma unroll
            for (int t = 0; t < 4; ++t) {
                const bf16x8 bw = *(const bf16x8*)(F.WSB + (size_t)(h * 128 + ph + 16 * t + fr) * 128 + 32 * ks + 8 * fq);
#pragma unroll
                for (int n = 0; n < 2; ++n) acc[n][t] = __builtin_amdgcn_mfma_f32_16x16x32_bf16(a[n], bw, acc[n][t], 0, 0, 0);
            }
        }
#pragma unroll
        for (int t = 0; t < 4; ++t) {
            const int p = ph + 16 * t + fr; const float bs = F.b_s[h * 128 + p];
            const v4u ug = *(const v4u*)(F.UG + (size_t)(m0 + p) * 512 + h * 128 + wcb + 8 * fq);
            v4u o;
            o.x = pk_bf16((acc[0][t][0] + bs) * bflo(ug.x), (acc[0][t][1] + bs) * bfhi(ug.x)); o.y = pk_bf16((acc[0][t][2] + bs) * bflo(ug.y), (acc[0][t][3] + bs) * bfhi(ug.y));
            o.z = pk_bf16((acc[1][t][0] + bs) * bflo(ug.z), (acc[1][t][1] + bs) * bfhi(ug.z)); o.w = pk_bf16((acc[1][t][2] + bs) * bflo(ug.w), (acc[1][t][3] + bs) * bfhi(ug.w));
            *(v4u*)(F.A2 + (size_t)(m0 + p) * 1024 + h * 128 + wcb + 8 * fq) = o;
        }
        __syncthreads();
    }
}
__device__ __forceinline__ void dft16(const float (&z)[16], float (&r)[16]) {
    constexpr float C16[16] = {1.f, 0.92387953251f, 0.70710678119f, 0.38268343237f, 0.f, -0.38268343237f, -0.70710678119f, -0.92387953251f, -1.f, -0.92387953251f, -0.70710678119f, -0.38268343237f, 0.f, 0.38268343237f, 0.70710678119f, 0.92387953251f};
    float e[8], o[8];
#pragma unroll
    for (int s = 1; s < 8; ++s) { e[s] = z[s] + z[16 - s]; o[s] = z[s] - z[16 - s]; }
#pragma unroll
    for (int k = 0; k <= 8; ++k) { float a = (k & 1) ? z[0] - z[8] : z[0] + z[8];
#pragma unroll
        for (int s = 1; s < 8; ++s) a += C16[(k * s) & 15] * e[s];
        r[k] = a; }
#pragma unroll
    for (int k = 1; k < 8; ++k) { float a = 0.f;
#pragma unroll
        for (int s = 1; s < 8; ++s) a -= C16[(k * s + 12) & 15] * o[s];
        r[8 + k] = a; }
}
__device__ __forceinline__ void p2_dft16(Frame& F, int di) {
    const int it = di * 512 + F.tid, cv = it & 63, s_lo = (it >> 6) & 127, b = it >> 13;
#pragma unroll 1
    for (int hf = 0; hf < 2; ++hf) {
        const bf16* zp = F.Z + ((size_t)(b * 2048 + s_lo)) * 512 + 8 * cv + 4 * hf;
        u32x2 in[16];
#pragma unroll
        for (int s = 0; s < 16; ++s) in[s] = *(const u32x2*)(zp + (size_t)s * 128 * 512);
        u32x2 outp[16];
#pragma unroll
        for (int jp = 0; jp < 2; ++jp) {
            float zl[16], zh[16], rl[16], rh[16];
#pragma unroll
            for (int s = 0; s < 16; ++s) { zl[s] = bflo(in[s][jp]); zh[s] = bfhi(in[s][jp]); }
            dft16(zl, rl); dft16(zh, rh);
#pragma unroll
            for (int pl = 0; pl < 16; ++pl) outp[pl][jp] = pk_bf16(rl[pl], rh[pl]);
        }
        bf16* xp = F.X1 + ((size_t)(b * 16) * 128 + s_lo) * 512 + 8 * cv + 4 * hf;
#pragma unroll
        for (int pl = 0; pl < 16; ++pl) *(u32x2*)(xp + (size_t)pl * 128 * 512) = outp[pl];
    }
}
__device__ __forceinline__ v4u pack8(const f32x16& x, int s) { v4u p; p.x = pk_bf16(x[8 * s], x[8 * s + 1]); p.y = pk_bf16(x[8 * s + 2], x[8 * s + 3]); p.z = pk_bf16(x[8 * s + 4], x[8 * s + 5]); p.w = pk_bf16(x[8 * s + 6], x[8 * s + 7]); return p; }
__device__ __forceinline__ void p3_unit_decode(int ui, int& b, int& k1) { b = ui >> 4; const int j = ui & 15; k1 = j < 8 ? j : (j == 8 ? 8 : 24 - j); }
__device__ __forceinline__ void p2_mtf(Frame& F) {
    const int gt = (F.vcu * NWAVES + F.wave) * 64 + F.lane, NT = F.G * NWAVES * 64;
    for (int i2 = gt; i2 < 2 * 32768; i2 += NT) { const int i = i2 & 32767, ln = i & 63, ks = (i >> 6) & 15, et = (i >> 10) & 3, c = (i >> 12) & 1, g = i >> 13;
        v4u t = *(const v4u*)(F.MT + ((size_t)(g * 256 + c * 128 + et * 32 + (ln & 31))) * 256 + 16 * ks + 8 * (ln >> 5));
        const unsigned fl = (i2 >= 32768 && ks >= 8) ? 0x80008000u : 0u; t.x ^= fl; t.y ^= fl; t.z ^= fl; t.w ^= fl;
        *(v4u*)(F.MTF + (size_t)i2 * 8) = t; }
}
__device__ __forceinline__ void p3_slab_dma(Frame& F, LAS unsigned char* slab, int b, int k1, int g) {
    const int k1p = k1 <= 8 ? k1 : 16 - k1; const bool has_im = (k1p != 0 && k1p != 8);
    const bf16* xr = F.X1 + ((size_t)(b * 16 + k1p) * 128) * 512 + g * 128; const bf16* xi = has_im ? F.X1 + ((size_t)(b * 16 + 8 + k1p) * 128) * 512 + g * 128 : xr;
#pragma unroll
    for (int i = 0; i < 8; ++i) { const int pc = i * 8 + F.wave, row = 2 * pc + (F.lane >> 5), c = (F.lane & 31) ^ (row & 15);
        const bf16* src = (c >= 16 ? xi : xr) + (size_t)row * 512 + (c & 15) * 8;
        __builtin_amdgcn_global_load_lds((const unsigned*)src, (LAS unsigned*)(slab + pc * 1024), 16, 0, 0); }
}
__device__ __forceinline__ void p3_fourier_all(Frame& F) {
    LAS unsigned char* slab = F.lds; LAS unsigned char* xb = F.lds + 65536;
    const int lane = F.lane, w = F.wave, r = lane & 31, hh = lane >> 5;
    const int et1 = w & 3, c1 = w >> 2;
    const int kt2 = w & 3, eh2 = w >> 2;
    bf16x8 bm[16];
#define P3_LDBM16(gg, cj) do { _Pragma("unroll") for (int q_ = 0; q_ < 16; ++q_) bm[q_] = *(const bf16x8*)(F.MTF + (size_t)(cj) * 262144 + ((((size_t)(gg) * 2 + c1) * 4 + et1) * 16 + q_) * 512 + lane * 8); } while (0)
    bool first = true;
#pragma unroll 1
    for (int ui = blockIdx.x; ui < 512; ui += F.G) {
        int b, k1; p3_unit_decode(ui, b, k1);
        const int k1p = k1 <= 8 ? k1 : 16 - k1; const bool has_im = (k1p != 0 && k1p != 8);
        bf16x8 Ef[16];
#pragma unroll
        for (int scs = 0; scs < 16; ++scs) Ef[scs] = *(const bf16x8*)(F.ECS + ((((size_t)k1 * 4 + kt2) * 16 + scs) * 64 + lane) * 8);
        if (first) { p3_slab_dma(F, slab, b, k1, 0); P3_LDBM16(0, k1 > 8 ? 1 : 0); asm volatile("s_waitcnt vmcnt(0)" ::: "memory"); __syncthreads(); first = false; }
        const int k2 = 32 * kt2 + r; const size_t tok = (size_t)b * 2048 + k1 + 16 * k2;
#pragma unroll 1
        for (int g = 0; g < 4; ++g) {
#pragma unroll
            for (int pass = 0; pass < 2; ++pass) {
                f32x16 Dt[2];
#pragma unroll
                for (int a = 0; a < 2; ++a)
#pragma unroll
                    for (int i = 0; i < 16; ++i) Dt[a][i] = 0.f;
#pragma unroll
                for (int ks = 0; ks < 16; ++ks) {
                    if (ks < 8 || has_im) {
#pragma unroll
                        for (int sti = 0; sti < 2; ++sti) { const int row = 32 * (2 * pass + sti) + r; const bf16x8 ax = *(const LAS bf16x8*)(slab + row * 512 + (((2 * ks + hh) ^ (row & 15)) << 4));
                            Dt[sti] = __builtin_amdgcn_mfma_f32_32x32x16_bf16(ax, bm[ks], Dt[sti], 0, 0, 0); }
                    }
                }
#pragma unroll
                for (int sti = 0; sti < 2; ++sti)
#pragma unroll
                    for (int s = 0; s < 2; ++s) *(LAS v4u*)(xb + (((((2 * pass + sti) * 2 + c1) * 2 + s) * 4 + et1) << 10) + lane * 16) = pack8(Dt[sti], s);
            }
            __syncthreads();
            const bool nxt_unit = (g == 3), has_next = !nxt_unit || (ui + F.G < 512);
            if (has_next) { int nb = b, nk1 = k1; if (nxt_unit) p3_unit_decode(ui + F.G, nb, nk1); p3_slab_dma(F, slab, nb, nk1, nxt_unit ? 0 : g + 1); P3_LDBM16(nxt_unit ? 0 : g + 1, nk1 > 8 ? 1 : 0); }
            f32x16 Yt[2];
#pragma unroll
            for (int a = 0; a < 2; ++a)
#pragma unroll
                for (int i = 0; i < 16; ++i) Yt[a][i] = 0.f;
#pragma unroll
            for (int scs = 0; scs < 16; ++scs)
#pragma unroll
                for (int eti = 0; eti < 2; ++eti) { const bf16x8 df = *(const LAS bf16x8*)(xb + ((scs * 4 + 2 * eh2 + eti) << 10) + lane * 16);
                    Yt[eti] = __builtin_amdgcn_mfma_f32_32x32x16_bf16(df, Ef[scs], Yt[eti], 0, 0, 0); }
#pragma unroll
            for (int eti = 0; eti < 2; ++eti)
#pragma unroll
                for (int qd = 0; qd < 4; ++qd) { const int e0 = g * 128 + (2 * eh2 + eti) * 32 + 8 * qd + 4 * hh; const f32x4 bias = *(const f32x4*)(F.b_f + e0); const u32x2 sgv = *(const u32x2*)(F.SGB + tok * 512 + e0);
                    u32x2 o; o.x = pk_bf16((Yt[eti][4 * qd + 0] + bias[0]) * bflo(sgv.x), (Yt[eti][4 * qd + 1] + bias[1]) * bfhi(sgv.x)); o.y = pk_bf16((Yt[eti][4 * qd + 2] + bias[2]) * bflo(sgv.y), (Yt[eti][4 * qd + 3] + bias[3]) * bfhi(sgv.y));
                    *(u32x2*)(F.A2 + tok * 1024 + 512 + e0) = o; }
            asm volatile("s_waitcnt vmcnt(0)" ::: "memory");
            __syncthreads();
        }
    }
#undef P3_LDBM16
}
__device__ __forceinline__ void p5_final_rows(Frame& F, int row0, int nrows) {
    const int lane = F.lane;
    f32x4 pg[4];
#pragma unroll
    for (int j = 0; j < 4; ++j) pg[j] = *(const f32x4*)(F.post_g + 4 * lane + 256 * j);
    for (int mb = row0 + 4 * F.wave; mb < row0 + nrows; mb += 4 * NWAVES) {
        float qv = F.YSQ[(size_t)mb * 16 + lane];
        u32x2 y[4][4]; f32x4 xv[4][4];
#pragma unroll
        for (int i = 0; i < 4; ++i) {
#pragma unroll
            for (int j = 0; j < 4; ++j) { y[i][j] = *(const u32x2*)(F.Y + (size_t)(mb + i) * D + 4 * lane + 256 * j); xv[i][j] = *(const f32x4*)(F.x + (size_t)(mb + i) * D + 4 * lane + 256 * j); } }
        qv += __shfl_xor(qv, 1); qv += __shfl_xor(qv, 2); qv += __shfl_xor(qv, 4); qv += __shfl_xor(qv, 8);
#pragma unroll
        for (int i = 0; i < 4; ++i) {
            const float rstd = rsqrtf(__shfl(qv, 16 * i) * (1.f / D) + EPS);
#pragma unroll
            for (int j = 0; j < 4; ++j) { const unsigned w0 = y[i][j].x, w1 = y[i][j].y;
                f32x4 o; o.x = xv[i][j].x + bflo(w0) * rstd * pg[j].x; o.y = xv[i][j].y + bfhi(w0) * rstd * pg[j].y; o.z = xv[i][j].z + bflo(w1) * rstd * pg[j].z; o.w = xv[i][j].w + bfhi(w1) * rstd * pg[j].w;
                *(f32x4*)(F.out + (size_t)(mb + i) * D + 4 * lane + 256 * j) = o; }
        }
    }
}

struct Args { const float* in[11]; float* out; unsigned char* ws; int ph_lo, ph_hi, li, pad; };
__global__ void __launch_bounds__(NWAVES * 64, 2) mega_fwd(Args args) {
    extern __shared__ __attribute__((aligned(16))) unsigned char lds[];
    Frame F;
    F.lds = (LAS unsigned char*)lds;
    F.MISC = (volatile LAS unsigned*)(F.lds + MISC_OFF);
    F.tid = threadIdx.x; F.lane = F.tid & 63; F.wave = __builtin_amdgcn_readfirstlane(F.tid >> 6);
    F.G = gridDim.x; { const int bx = blockIdx.x; F.vcu = (F.G % 8 == 0) ? (bx % 8) * (F.G / 8) + bx / 8 : bx; }
    unsigned char* ws = args.ws;
    F.ctl = (gu32*)(ws + WS_CTL);
    F.x = args.in[0]; F.pre_g = args.in[1]; F.post_g = args.in[2]; F.w_in = args.in[3]; F.ln_g = args.in[4]; F.ln_b = args.in[5]; F.w_s = args.in[6]; F.b_s = args.in[7];
    F.w_f = args.in[8]; F.b_f = args.in[9]; F.w_out = args.in[10]; F.out = args.out;
    F.WIN = (bf16*)(ws + WS_WIN); F.WOUT = (bf16*)(ws + WS_WOUT); F.WSB = (bf16*)(ws + WS_WSB); F.MT = (bf16*)(ws + WS_MT); F.MTF = (bf16*)(ws + WS_MTF); F.ECS = (bf16*)(ws + WS_ECS);
    F.H = (bf16*)(ws + WS_H); F.UG = (bf16*)(ws + WS_UG); F.GV = (bf16*)(ws + WS_GV); F.Z = (bf16*)(ws + WS_Z); F.SGB = (bf16*)(ws + WS_SGB); F.X1 = (bf16*)(ws + WS_X1);
    F.A2 = (bf16*)(ws + WS_A2); F.Y = (bf16*)(ws + WS_Y); F.VSTP = (float*)(ws + WS_VSTP); F.YSQ = (float*)(ws + WS_YSQ);
    for (int u = F.tid; u < (LDS_BYTES - LDSCTL_OFF) / 4; u += NWAVES * 64) ((LAS unsigned*)(F.lds + LDSCTL_OFF))[u] = 0u;
    __syncthreads();
    XcdBarrier bar; bar.bar = (unsigned*)(F.ctl + CW_BAR); bar.x = 0; bar.st = nullptr;
    if (N_LAUNCHES != PER_PHASE) bar = xcd_barrier_post((unsigned*)(F.ctl + CW_BAR), F.MISC + 8);
#define GRID_BAR() do { if (N_LAUNCHES != PER_PHASE) xcd_barrier(bar); } while (0)
    const int lo = args.ph_lo, hi = args.ph_hi;
#define IN(k) (lo <= (k) && (k) < hi)
#define BOTH(k) (IN(k) && IN((k) + 1))
    if (IN(0)) { p0_prologue(F); if (BOTH(0)) GRID_BAR(); }
    if (IN(1)) {
        pg8::Gemm g{F.H, F.WIN, M, DIN, D}; pg8::StaticOrder S; S.init(M, DIN, F.G, (int)blockIdx.x);
        pg8::EpiIn E{F.UG, F.GV, F.Z, F.SGB, F.VSTP};
        pg8::gemm_phase<pg8::EpiIn, pg8::StaticOrder, true, true>(F.lds + RING_OFF, g, S, E);
        if (BOTH(1)) GRID_BAR();
    }
    if (IN(2)) {
        p2_mtf(F);
        for (int i = blockIdx.x; i < 1024; i += F.G) { if (i < 512) p2_spatial(F, i); else p2_dft16(F, i - 512); }
        if (BOTH(2)) GRID_BAR();
    }
    if (IN(3)) {
        p3_fourier_all(F);
        if (BOTH(3)) GRID_BAR();
    }
    if (IN(4)) {
        pg8::Gemm g{F.A2, F.WOUT, M, D, D}; pg8::PanelOrder S{F.G, F.vcu, M / 256, D / 256};
        pg8::EpiY E{F.Y, F.YSQ};
        pg8::gemm_phase<pg8::EpiY, pg8::PanelOrder, true, true>(F.lds + RING_OFF, g, S, E);
        __builtin_amdgcn_fence(__ATOMIC_ACQUIRE, "agent");
        for (int pm = F.vcu; pm < M / 256; pm += F.G) p5_final_rows(F, pm * 256, 256);
    }
#undef IN
#undef BOTH
}

extern "C" void kernel_launch(void* const* d_in, const int* in_sizes, int n_in, void* d_out, int out_size, void* d_ws, size_t ws_size, hipStream_t stream) {
    static int grid = 0;
    if (grid == 0) {
        if (n_in != 11 || in_sizes[0] != M * D || out_size != M * D || ws_size < WS_END) { fprintf(stderr, "kernel_launch: unexpected shapes / workspace (n_in %d, in0 %d, out %d, ws %zu)\n", n_in, n_in > 0 ? in_sizes[0] : -1, out_size, ws_size); grid = -1; return; }
        int dev = 0, cus = 0, per_cu = 0;
        if (hipGetDevice(&dev) != hipSuccess || hipDeviceGetAttribute(&cus, hipDeviceAttributeMultiprocessorCount, dev) != hipSuccess) { grid = -1; return; }
        if (hipFuncSetAttribute((const void*)mega_fwd, hipFuncAttributeMaxDynamicSharedMemorySize, LDS_BYTES) != hipSuccess) { fprintf(stderr, "kernel_launch: hipFuncSetAttribute failed\n"); grid = -1; return; }
        if (hipOccupancyMaxActiveBlocksPerMultiprocessor(&per_cu, (const void*)mega_fwd, NWAVES * 64, LDS_BYTES) != hipSuccess || per_cu < 1) { fprintf(stderr, "kernel_launch: occupancy query says %d blocks per CU\n", per_cu); (void)hipGetLastError(); per_cu = 1; }
        grid = cus;
    }
    if (grid < 0) return;
    (void)hipMemsetAsync((char*)d_ws + WS_CTL, 0, CTL_ZERO_BYTES, stream);
    Args a; memset(&a, 0, sizeof(a));
    for (int i = 0; i < 11; ++i) a.in[i] = (const float*)d_in[i];
    a.out = (float*)d_out; a.ws = (unsigned char*)d_ws;
    for (int li = 0; li < N_LAUNCHES; ++li) {
        a.ph_lo = (N_LAUNCHES == PER_PHASE) ? li : 0; a.ph_hi = (N_LAUNCHES == PER_PHASE) ? li + 1 : PER_PHASE; a.li = li;
        hipLaunchKernelGGL(mega_fwd, dim3(grid), dim3(NWAVES * 64), LDS_BYTES, stream, a);
    }
    if (PROBE_REPEAT >= 0) { a.ph_lo = PROBE_REPEAT; a.ph_hi = PROBE_REPEAT + 1; a.li = 1; hipLaunchKernelGGL(mega_fwd, dim3(grid), dim3(NWAVES * 64), LDS_BYTES, stream, a); }
}
```

```cpp
#include <hip/hip_runtime.h>
#include <cstdio>
#include <cstdint>
#include <cstring>

namespace pg8 {
#define PG8_LAS __attribute__((address_space(3)))
typedef unsigned short bf16_t;
typedef short bf16x8 __attribute__((ext_vector_type(8)));
typedef float f32x4 __attribute__((ext_vector_type(4)));
typedef unsigned u32x4 __attribute__((ext_vector_type(4)));
constexpr int BM = 256, BK = 64, HALF = 128, HTB = HALF * BK * 2  , STAGE_BYTES = 8 * HTB, NXCD = 8, WGM = 8;

__host__ __device__ __forceinline__ int lds_byte(int r, int c) { const int st = (r >> 4) * 2 + (c >> 5), rr = r & 15, cc = c & 31, ob = rr * 64 + cc * 2; return st * 1024 + (ob ^ (((ob >> 9) & 1) << 5)); }
__host__ __device__ __forceinline__ void stage_rc(int b, int& R, int& C) { const int st = b / 1024, sb = b % 1024, swz = sb ^ (((sb >> 9) & 1) << 5); R = (st >> 1) * 16 + swz / 64; C = (st & 1) * 32 + (swz % 64) / 2; }
__host__ __device__ __forceinline__ int perm32(int rho) { const int n = rho >> 4, i = rho & 15; return 8 * (i >> 2) + 4 * n + (i & 3); }

struct Unit { int pm, pn; };
struct Gemm { const bf16_t* A; const bf16_t* Bt; int M, N, K; };

struct StaticOrder {
    int nM, nN, nwg, G, c;
    __host__ __device__ void init(int M, int N, int G_, int c_) { nM = M / BM; nN = N / BM; nwg = nM * nN; G = G_; c = c_; }
    __host__ __device__ bool next(int i, Unit& u) const {
        const long L = (long)i * G + c; if (L >= nwg) return false;
        int wgid = (int)L; { const int q = nwg / NXCD, r = nwg % NXCD, xcd = wgid % NXCD, off = wgid / NXCD; wgid = (xcd < r ? xcd * (q + 1) : r * (q + 1) + (xcd - r) * q) + off; }
        const int nig = WGM * nN, gid = wgid / nig, fm = gid * WGM, gsz = (nM - fm) < WGM ? (nM - fm) : WGM;
        u.pm = fm + ((wgid % nig) % gsz); u.pn = (wgid % nig) / gsz; return true;
    }
    __device__ __forceinline__ void a_ready(const Unit&) const {}
    __device__ __forceinline__ void done(const Unit&) const {}
};

typedef float f32x2 __attribute__((ext_vector_type(2)));
__device__ __forceinline__ f32x2 gelu_pk(f32x2 v) {
    const f32x2 av = __builtin_elementwise_abs(v), d = av * 0.2316418882f + 1.0f;
    f32x2 t; t.x = __builtin_amdgcn_rcpf(d.x); t.y = __builtin_amdgcn_rcpf(d.y);
    f32x2 q = t * 0.5307027145f + (-0.7265760135f); q = q * t + 0.7107068705f; q = q * t + (-0.142248368f); q = q * t + 0.127414796f; q = q * t;
    const f32x2 s = (v * v) * (-0.72134752044f);
    f32x2 e; e.x = __builtin_amdgcn_exp2f(s.x); e.y = __builtin_amdgcn_exp2f(s.y);
    const f32x2 m = v * (q * e), r = v - m;
    f32x2 o; o.x = v.x < 0.f ? m.x : r.x; o.y = v.y < 0.f ? m.y : r.y; return o;
}
typedef __bf16 bf16x2_t __attribute__((ext_vector_type(2)));
__device__ __forceinline__ unsigned pk_bf16(float lo, float hi) { const f32x2 f = {lo, hi}; return __builtin_bit_cast(unsigned, __builtin_convertvector(f, bf16x2_t)); }
__device__ __forceinline__ float silu_f(float v) { return v * __builtin_amdgcn_rcpf(1.0f + __builtin_amdgcn_exp2f(-1.44269504089f * v)); }
struct EpiIn {
    static constexpr bool PERM = true, AFTER_DRAIN = false;
    bf16_t *UG, *GV, *Z, *SGB; float* VSTP;
    __device__ __forceinline__ void operator()(const f32x4 (&acc)[2][2][4][2], const Unit& u, int wr, int wc, int fr, int fq) const {
        const int row0 = u.pm * BM + wr * 64 + fr, cl = wc * 32 + 8 * fq;
        if (u.pn < 4) {
            bf16_t* base = UG + (size_t)row0 * 512 + u.pn * 128 + cl;
#pragma unroll
            for (int ai = 0; ai < 2; ++ai)
#pragma unroll
                for (int m = 0; m < 4; ++m) {
                    const f32x4 a0 = acc[ai][0][m][0], a1 = acc[ai][0][m][1], g0 = acc[ai][1][m][0], g1 = acc[ai][1][m][1];
                    const f32x2 p0 = gelu_pk((f32x2){a0[0], a0[1]}), p1 = gelu_pk((f32x2){a0[2], a0[3]}), p2 = gelu_pk((f32x2){a1[0], a1[1]}), p3 = gelu_pk((f32x2){a1[2], a1[3]});
                    u32x4 w;
                    w.x = pk_bf16(p0.x * silu_f(g0[0]), p0.y * silu_f(g0[1])); w.y = pk_bf16(p1.x * silu_f(g0[2]), p1.y * silu_f(g0[3]));
                    w.z = pk_bf16(p2.x * silu_f(g1[0]), p2.y * silu_f(g1[1])); w.w = pk_bf16(p3.x * silu_f(g1[2]), p3.y * silu_f(g1[3]));
                    *(u32x4*)(base + (size_t)(ai * HALF + m * 16) * 512) = w;
                }
        } else if (u.pn < 6) {
            bf16_t* base = GV + (size_t)row0 * 512 + (u.pn - 4) * 256 + cl;
            float* sp = VSTP + (size_t)row0 * 16 + ((u.pn - 4) * 4 + wc) * 2;
#pragma unroll
            for (int ai = 0; ai < 2; ++ai)
#pragma unroll
                for (int m = 0; m < 4; ++m) {
                    float s = 0.f, q = 0.f;
#pragma unroll
                    for (int bj = 0; bj < 2; ++bj) {
                        const f32x4 a0 = acc[ai][bj][m][0], a1 = acc[ai][bj][m][1];
                        const f32x2 p0 = gelu_pk((f32x2){a0[0], a0[1]}), p1 = gelu_pk((f32x2){a0[2], a0[3]}), p2 = gelu_pk((f32x2){a1[0], a1[1]}), p3 = gelu_pk((f32x2){a1[2], a1[3]});
                        s += ((p0.x + p0.y) + (p1.x + p1.y)) + ((p2.x + p2.y) + (p3.x + p3.y));
                        q += ((p0.x * p0.x + p0.y * p0.y) + (p1.x * p1.x + p1.y * p1.y)) + ((p2.x * p2.x + p2.y * p2.y) + (p3.x * p3.x + p3.y * p3.y));
                        u32x4 w; w.x = pk_bf16(p0.x, p0.y); w.y = pk_bf16(p1.x, p1.y); w.z = pk_bf16(p2.x, p2.y); w.w = pk_bf16(p3.x, p3.y);
                        *(u32x4*)(base + (size_t)(ai * HALF + m * 16) * 512 + bj * HALF) = w;
                    }
                    s += __shfl_xor(s, 16); s += __shfl_xor(s, 32); q += __shfl_xor(q, 16); q += __shfl_xor(q, 32);
                    if (fq == 0) *(f32x2*)(sp + (size_t)(ai * HALF + m * 16) * 16) = (f32x2){s, q};
                }
        } else {
            const bool act = u.pn >= 8;
            bf16_t* base = (act ? SGB + (size_t)(u.pn - 8) * 256 : Z + (size_t)(u.pn - 6) * 256) + (size_t)row0 * 512 + cl;
#pragma unroll
            for (int ai = 0; ai < 2; ++ai)
#pragma unroll
                for (int m = 0; m < 4; ++m)
#pragma unroll
                    for (int bj = 0; bj < 2; ++bj) {
                        f32x4 a0 = acc[ai][bj][m][0], a1 = acc[ai][bj][m][1];
                        if (act) { a0 = (f32x4){silu_f(a0[0]), silu_f(a0[1]), silu_f(a0[2]), silu_f(a0[3])}; a1 = (f32x4){silu_f(a1[0]), silu_f(a1[1]), silu_f(a1[2]), silu_f(a1[3])}; }
                        u32x4 w; w.x = pk_bf16(a0[0], a0[1]); w.y = pk_bf16(a0[2], a0[3]); w.z = pk_bf16(a1[0], a1[1]); w.w = pk_bf16(a1[2], a1[3]);
                        *(u32x4*)(base + (size_t)(ai * HALF + m * 16) * 512 + bj * HALF) = w;
                    }
        }
    }
};
struct EpiY {
    static constexpr bool PERM = true, AFTER_DRAIN = false;
    bf16_t* Y; float* YSQ;
    __device__ __forceinline__ void operator()(const f32x4 (&acc)[2][2][4][2], const Unit& u, int wr, int wc, int fr, int fq) const {
        const int row0 = u.pm * BM + wr * 64 + fr, cl = wc * 32 + 8 * fq;
        bf16_t* base = Y + (size_t)row0 * 1024 + u.pn * 256 + cl;
        float* sp = YSQ + (size_t)row0 * 16 + u.pn * 4 + wc;
#pragma unroll
        for (int ai = 0; ai < 2; ++ai)
#pragma unroll
            for (int m = 0; m < 4; ++m) {
                float q = 0.f;
#pragma unroll
                for (int bj = 0; bj < 2; ++bj) {
                    const f32x4 a0 = acc[ai][bj][m][0], a1 = acc[ai][bj][m][1];
                    q += ((a0[0] * a0[0] + a0[1] * a0[1]) + (a0[2] * a0[2] + a0[3] * a0[3])) + ((a1[0] * a1[0] + a1[1] * a1[1]) + (a1[2] * a1[2] + a1[3] * a1[3]));
                    u32x4 w; w.x = pk_bf16(a0[0], a0[1]); w.y = pk_bf16(a0[2], a0[3]); w.z = pk_bf16(a1[0], a1[1]); w.w = pk_bf16(a1[2], a1[3]);
                    *(u32x4*)(base + (size_t)(ai * HALF + m * 16) * 1024 + bj * HALF) = w;
                }
                q += __shfl_xor(q, 16); q += __shfl_xor(q, 32);
                if (fq == 0) sp[(size_t)(ai * HALF + m * 16) * 16] = q;
            }
    }
};
struct PanelOrder {
    int G, c, nM, nN;
    __device__ __forceinline__ bool next(int i, Unit& u) const { const int pm = c + G * (i / nN); if (pm >= nM) return false; u.pm = pm; u.pn = i % nN; return true; }
    __device__ __forceinline__ void a_ready(const Unit&) const {}
    __device__ __forceinline__ void done(const Unit&) const {}
};


template <class Epi, class Sched, bool ALIGN_EPI = false, bool SP2 = false>
__device__ __forceinline__ void gemm_phase(PG8_LAS unsigned char* lds, const Gemm g, const Sched& S, const Epi& E) {
    const int tid = threadIdx.x, wid = __builtin_amdgcn_readfirstlane(tid >> 6), lane = tid & 63, wr = wid >> 2, wc = wid & 3, fr = lane & 15, fq = lane >> 4;
    const int K = g.K, nt = K / BK;
    unsigned voffA[2], voffB[2];
#pragma unroll
    for (int i = 0; i < 2; ++i) { int R, C; stage_rc(tid * 16 + i * 8192, R, C); const int Rb = Epi::PERM ? ((R & ~31) + perm32(R & 31)) : R;
        voffA[i] = (unsigned)(R * K + C) * 2u; voffB[i] = (unsigned)(Rb * K + C) * 2u; }
    const size_t kstep = (size_t)(BK * 2);
    const size_t hstep = (size_t)HALF * K * 2;
    const size_t tstep = 2 * hstep;
    const unsigned ldsw = (unsigned)wid * 1024u;
    const int aoff = lds_byte(wr * 64 + fr, fq * 8), boff = lds_byte(wc * 32 + fr, fq * 8);
#define PG8_SA(b, h) (((b) * 2 + (h)) * HTB)
#define PG8_SB(b, h) ((4 + (b) * 2 + (h)) * HTB)
#define PG8_STAGE(bufoff, gbase, voff) do { _Pragma("unroll") for (int _i = 0; _i < 2; ++_i) \
        __builtin_amdgcn_global_load_lds((const unsigned*)((const char*)(gbase) + (voff)[_i]), (PG8_LAS unsigned*)(lds + (bufoff) + ldsw + _i * 8192), 16, 0, 0); } while (0)
#define PG8_LDA(dst, b, h) do { _Pragma("unroll") for (int m = 0; m < 4; ++m) _Pragma("unroll") for (int k = 0; k < 2; ++k) dst[m][k] = *(const PG8_LAS bf16x8*)(lds + PG8_SA(b, h) + aoff + m * 2048 + k * 1024); } while (0)
#define PG8_LDB(dst, b, h) do { _Pragma("unroll") for (int n = 0; n < 2; ++n) _Pragma("unroll") for (int k = 0; k < 2; ++k) dst[n][k] = *(const PG8_LAS bf16x8*)(lds + PG8_SB(b, h) + boff + n * 2048 + k * 1024); } while (0)
#define PG8_MMA(ai, bj, At, Bt) do { __builtin_amdgcn_s_setprio(1); _Pragma("unroll") for (int m = 0; m < 4; ++m) _Pragma("unroll") for (int n = 0; n < 2; ++n) _Pragma("unroll") for (int k = 0; k < 2; ++k) \
        acc[ai][bj][m][n] = __builtin_amdgcn_mfma_f32_16x16x32_bf16(Bt[n][k], At[m][k], acc[ai][bj][m][n], 0, 0, 0); __builtin_amdgcn_s_setprio(0); } while (0)
#define PG8_WAIT_V(n) asm volatile("s_waitcnt vmcnt(" #n ")" ::: "memory")
#define PG8_WAIT_L(n) asm volatile("s_waitcnt lgkmcnt(" #n ")" ::: "memory")
#define PG8_BAR __builtin_amdgcn_s_barrier()
#define PG8_SCHED __builtin_amdgcn_sched_barrier(0)
    Unit cur, nxt; int ui = 0;
    if (!S.next(0, cur)) return;
    f32x4 acc[2][2][4][2];
#pragma unroll
    for (int a = 0; a < 2; ++a)
#pragma unroll
        for (int b = 0; b < 2; ++b)
#pragma unroll
            for (int m = 0; m < 4; ++m)
#pragma unroll
                for (int n = 0; n < 2; ++n) acc[a][b][m][n] = (f32x4){0.f, 0.f, 0.f, 0.f};
    bf16x8 At[4][2], B0[2][2], B1[2][2];
    const char* cA = (const char*)g.A + (size_t)cur.pm * tstep; const char* cB = (const char*)g.Bt + (size_t)cur.pn * tstep;
    S.a_ready(cur);
    if constexpr (SP2) {
        PG8_STAGE(PG8_SB(0, 0), cB, voffB); PG8_STAGE(PG8_SB(0, 1), cB + hstep, voffB); PG8_STAGE(PG8_SA(0, 0), cA, voffA); PG8_STAGE(PG8_SA(0, 1), cA + hstep, voffA);
        if (wr == 1) PG8_BAR;
        PG8_WAIT_V(2); PG8_BAR;
        PG8_STAGE(PG8_SB(1, 0), cB + kstep, voffB); PG8_STAGE(PG8_SA(1, 0), cA + kstep, voffA); PG8_STAGE(PG8_SB(1, 1), cB + hstep + kstep, voffB);
        PG8_WAIT_V(6); PG8_BAR;
    } else {
        PG8_STAGE(PG8_SB(0, 0), cB, voffB); PG8_STAGE(PG8_SA(0, 0), cA, voffA); PG8_STAGE(PG8_SB(0, 1), cB + hstep, voffB); PG8_STAGE(PG8_SA(0, 1), cA + hstep, voffA);
        if (wr == 1) PG8_BAR;
        PG8_WAIT_V(4); PG8_BAR;
        PG8_STAGE(PG8_SB(1, 0), cB + kstep, voffB); PG8_STAGE(PG8_SA(1, 0), cA + kstep, voffA); PG8_STAGE(PG8_SB(1, 1), cB + hstep + kstep, voffB);
        PG8_WAIT_V(6); PG8_BAR;
    }
    for (;;) {
        const bool has_next = S.next(ui + 1, nxt);
        const char* nA = has_next ? (const char*)g.A + (size_t)nxt.pm * tstep : cA; const char* nB = has_next ? (const char*)g.Bt + (size_t)nxt.pn * tstep : cB;
        for (int t = 0; t < nt; t += 2) {
            const bool last = (t == nt - 2);
            const char* a1 = cA + (size_t)(t + 1) * kstep;
            const char* a2 = last ? nA : cA + (size_t)(t + 2) * kstep; const char* b2 = last ? nB : cB + (size_t)(t + 2) * kstep;
            const char* a3 = a2 + kstep; const char* b3 = b2 + kstep;
            if (last && has_next) S.a_ready(nxt);
            if constexpr (SP2) {
            PG8_LDB(B0, 0, 0); PG8_LDB(B1, 0, 1); PG8_SCHED; PG8_LDA(At, 0, 0); PG8_STAGE(PG8_SA(1, 1), a1 + hstep, voffA);
            PG8_WAIT_V(8); PG8_WAIT_L(0); PG8_BAR; PG8_MMA(0, 0, At, B0); PG8_MMA(0, 1, At, B1); PG8_BAR; PG8_SCHED;
            PG8_LDA(At, 0, 1); PG8_STAGE(PG8_SB(0, 0), b2, voffB); PG8_STAGE(PG8_SB(0, 1), b2 + hstep, voffB); PG8_STAGE(PG8_SA(0, 0), a2, voffA);
            PG8_WAIT_V(8); PG8_WAIT_L(0); PG8_BAR; PG8_MMA(1, 0, At, B0); PG8_MMA(1, 1, At, B1); PG8_BAR; PG8_SCHED;
            PG8_LDB(B0, 1, 0); PG8_LDB(B1, 1, 1); PG8_SCHED; PG8_LDA(At, 1, 0); PG8_STAGE(PG8_SA(0, 1), a2 + hstep, voffA);
            PG8_WAIT_V(8); PG8_WAIT_L(0); PG8_BAR; PG8_MMA(0, 0, At, B0); PG8_MMA(0, 1, At, B1); PG8_BAR; PG8_SCHED;
            PG8_LDA(At, 1, 1); PG8_STAGE(PG8_SB(1, 0), b3, voffB); PG8_STAGE(PG8_SB(1, 1), b3 + hstep, voffB); PG8_STAGE(PG8_SA(1, 0), a3, voffA);
            PG8_WAIT_V(8); PG8_WAIT_L(0); PG8_BAR; PG8_MMA(1, 0, At, B0); PG8_MMA(1, 1, At, B1); PG8_BAR; PG8_SCHED;
            } else {
            PG8_LDB(B0, 0, 0); PG8_SCHED; PG8_LDA(At, 0, 0); PG8_STAGE(PG8_SA(1, 1), a1 + hstep, voffA);
            PG8_WAIT_L(8); PG8_BAR; PG8_WAIT_L(0); PG8_MMA(0, 0, At, B0); PG8_BAR; PG8_SCHED;
            PG8_LDB(B1, 0, 1); PG8_STAGE(PG8_SB(0, 0), b2, voffB);
            PG8_BAR; PG8_WAIT_L(0); PG8_MMA(0, 1, At, B1); PG8_BAR;
            PG8_LDA(At, 0, 1); PG8_STAGE(PG8_SA(0, 0), a2, voffA);
            PG8_BAR; PG8_WAIT_L(0); PG8_MMA(1, 0, At, B0); PG8_BAR; PG8_SCHED;
            PG8_STAGE(PG8_SB(0, 1), b2 + hstep, voffB);
            PG8_WAIT_V(6); PG8_BAR; PG8_MMA(1, 1, At, B1); PG8_BAR;
            PG8_LDB(B0, 1, 0); PG8_SCHED; PG8_LDA(At, 1, 0); PG8_STAGE(PG8_SA(0, 1), a2 + hstep, voffA);
            PG8_WAIT_L(8); PG8_BAR; PG8_WAIT_L(0); PG8_MMA(0, 0, At, B0); PG8_BAR; PG8_SCHED;
            PG8_LDB(B1, 1, 1); PG8_STAGE(PG8_SB(1, 0), b3, voffB);
            PG8_BAR; PG8_WAIT_L(0); PG8_MMA(0, 1, At, B1); PG8_BAR;
            PG8_LDA(At, 1, 1); PG8_STAGE(PG8_SA(1, 0), a3, voffA);
            PG8_BAR; PG8_WAIT_L(0); PG8_MMA(1, 0, At, B0); PG8_BAR; PG8_SCHED;
            PG8_STAGE(PG8_SB(1, 1), b3 + hstep, voffB);
            PG8_WAIT_V(6); PG8_BAR; PG8_MMA(1, 1, At, B1); PG8_BAR;
            }
        }
        if constexpr (ALIGN_EPI) { if (wr == 0) PG8_BAR; }
        if constexpr (!Epi::AFTER_DRAIN) { E(acc, cur, wr, wc, fr, fq); S.done(cur); }
        if (!has_next) break;
#pragma unroll
        for (int a = 0; a < 2; ++a)
#pragma unroll
            for (int b = 0; b < 2; ++b)
#pragma unroll
                for (int m = 0; m < 4; ++m)
#pragma unroll
                    for (int n = 0; n < 2; ++n) acc[a][b][m][n] = (f32x4){0.f, 0.f, 0.f, 0.f};
        cur = nxt; cA = nA; cB = nB; ++ui;
        if constexpr (ALIGN_EPI) { if (wr == 1) PG8_BAR; }
    }
    PG8_WAIT_V(0);
    if constexpr (!ALIGN_EPI) { if (wr == 0) PG8_BAR; }
    PG8_BAR;
    if constexpr (Epi::AFTER_DRAIN) { E.fused(acc, cur, wr, wc, fr, fq, lds, wid, lane); S.done(cur); }
#undef PG8_SA
#undef PG8_SB
#undef PG8_STAGE
#undef PG8_LDA
#undef PG8_LDB
#undef PG8_MMA
#undef PG8_WAIT_V
#undef PG8_WAIT_L
#undef PG8_BAR
#undef PG8_SCHED
}
}
constexpr int NWAVES = 8;
#ifndef MK_N_LAUNCHES
#define MK_N_LAUNCHES 1
#endif
constexpr int N_LAUNCHES = MK_N_LAUNCHES;
constexpr int PER_PHASE = 5;
#ifndef PROBE_REPEAT
#define PROBE_REPEAT -1
#endif

constexpr int BATCH = 32, SEQ = 2048, D = 1024, DA = 512, DB = 512, DIN = 2560;
constexpr int M = BATCH * SEQ;
constexpr float EPS = 1e-6f;

constexpr size_t MiB = 1u << 20;
constexpr size_t WS_CTL = 0, CTL_ZERO_BYTES = 1 * MiB;
constexpr size_t WS_WIN = 2 * MiB;
constexpr size_t WS_WOUT = 8 * MiB;
constexpr size_t WS_WSB = 10 * MiB;
constexpr size_t WS_MT = 11 * MiB;
constexpr size_t WS_ECS = 12 * MiB;
constexpr size_t WS_MTF = 13 * MiB;
constexpr size_t WS_VSTP = 14 * MiB;
constexpr size_t WS_YSQ = 18 * MiB;
constexpr size_t WS_H = 32 * MiB;
constexpr size_t WS_UG = 160 * MiB;
constexpr size_t WS_GV = 224 * MiB;
constexpr size_t WS_Z = 288 * MiB;
constexpr size_t WS_SGB = 352 * MiB;
constexpr size_t WS_X1 = 416 * MiB;
constexpr size_t WS_A2 = 480 * MiB;
constexpr size_t WS_Y = 608 * MiB;
constexpr size_t WS_END = 736 * MiB;
constexpr int CW_TMO = 0, CW_CODE = 1, CW_BAR = 4096;

constexpr int RING_OFF = 0, RING_BYTES = 131072;
constexpr int LDSCTL_OFF = RING_BYTES, MISC_OFF = LDSCTL_OFF + 320;
constexpr int LDS_BYTES = 147456;
static_assert(MISC_OFF + 128 <= LDS_BYTES, "LDS map");


#define GAS __attribute__((address_space(1)))
#define LAS __attribute__((address_space(3)))
typedef unsigned short bf16;
typedef unsigned v4u __attribute__((ext_vector_type(4)));
typedef float f32x4 __attribute__((ext_vector_type(4)));
typedef short bf16x8 __attribute__((ext_vector_type(8)));
typedef GAS unsigned gu32;
typedef GAS unsigned long long gu64;
#define RLX_AGENT __ATOMIC_RELAXED, __HIP_MEMORY_SCOPE_AGENT
#define LDS_WAIT() asm volatile("s_waitcnt lgkmcnt(0)" ::: "memory")
#define VM_WAIT() asm volatile("s_waitcnt vmcnt(0)" ::: "memory")
__device__ __forceinline__ unsigned long long rt() { return __builtin_amdgcn_s_memrealtime(); }
__device__ __forceinline__ unsigned f2bf(float f) { unsigned u = __builtin_bit_cast(unsigned, f); return (u + 0x7fffu + ((u >> 16) & 1u)) >> 16; }
__device__ __forceinline__ unsigned pk2(float lo, float hi) { return f2bf(lo) | (f2bf(hi) << 16); }
#define XB_TMO      128
#define XB_XCNT(j)  (256  + 64 * (j))
#define XB_XSUB(j)  (1280 + 64 * (j))
#define XB_XGEN(j)  (2304 + 64 * (j))
#define XB_TOP      3328
#define XB_TOPGEN   3392
#define XCD_BAR_WORDS 3456
#define XB_SPIN_CAP (1u << 18)

__device__ __forceinline__ unsigned xb_ld(unsigned* p)              { return __hip_atomic_load(p, __ATOMIC_RELAXED, __HIP_MEMORY_SCOPE_AGENT); }
__device__ __forceinline__ unsigned xb_add(unsigned* p, unsigned v) { return __hip_atomic_fetch_add(p, v, __ATOMIC_RELAXED, __HIP_MEMORY_SCOPE_AGENT); }
__device__ __forceinline__ unsigned xb_xcc_id() { return (unsigned)__builtin_amdgcn_s_getreg((3 << 11) | 20) & 0xFu; }
#define XB_SPIN(cond, bar) do { unsigned _sp = 0; while (cond) { __builtin_amdgcn_s_sleep(1); \
    if ((++_sp & 255u) == 0u) { if (xb_ld(&(bar)[XB_TMO])) break; if (_sp > XB_SPIN_CAP) { atomicAdd(&(bar)[XB_TMO], 1u); break; } } } } while (0)

struct XcdBarrier {
    unsigned* bar; unsigned x;
    volatile LAS unsigned* st;
};

__device__ __forceinline__ XcdBarrier xcd_barrier_post(unsigned* bar, volatile LAS unsigned* st) {
    XcdBarrier b; b.bar = bar; b.x = xb_xcc_id(); b.st = st;
    if (threadIdx.x == 0) (void)xb_add(&bar[XB_XCNT(b.x)], 1u);
    return b;
}
__device__ __forceinline__ void xcd_barrier_complete(unsigned* bar, unsigned x, unsigned& nloc, unsigned& nx) {
    const unsigned G = gridDim.x * gridDim.y * gridDim.z;
    unsigned sum, cnt, mine, sp = 0u;
    for (;;) {
        sum = 0u; cnt = 0u; mine = 0u;
#pragma unroll
        for (unsigned j = 0; j < 16; ++j) { const unsigned c = xb_ld(&bar[XB_XCNT(j)]); sum += c; cnt += (c > 0u) ? 1u : 0u; mine = (j == x) ? c : mine; }
        if (sum == G) break;
        __builtin_amdgcn_s_sleep(1);
        if ((++sp & 255u) == 0u) { if (xb_ld(&bar[XB_TMO])) break; if (sp > XB_SPIN_CAP) { atomicAdd(&bar[XB_TMO], 1u); break; } }
    }
    nloc = mine > 0u ? mine : 1u; nx = cnt > 0u ? cnt : 1u;
}

__device__ __forceinline__ void xcd_barrier(const XcdBarrier& b) {
    asm volatile("s_waitcnt vmcnt(0)" ::: "memory");
    __syncthreads();
    if (threadIdx.x == 0) {
        unsigned* bar = b.bar;
        __builtin_amdgcn_s_waitcnt(0);
        unsigned nloc = b.st[0], nx = b.st[1];
        if (nloc == 0u) { xcd_barrier_complete(bar, b.x, nloc, nx); b.st[0] = nloc; b.st[1] = nx; }
        const unsigned old = xb_add(&bar[XB_XSUB(b.x)], 1u);
        const unsigned gen = old / nloc;
        if (old + 1u == (gen + 1u) * nloc) {
            __builtin_amdgcn_fence(__ATOMIC_RELEASE, "agent");
            asm volatile("s_waitcnt vmcnt(0)" ::: "memory");
            const unsigned og = xb_add(&bar[XB_TOP], 1u);
            const unsigned tg = og / nx;
            if (og + 1u == (tg + 1u) * nx) xb_add(&bar[XB_TOPGEN], 1u);
            else XB_SPIN(xb_ld(&bar[XB_TOPGEN]) == tg, bar);
            __builtin_amdgcn_fence(__ATOMIC_ACQUIRE, "agent");
            xb_add(&bar[XB_XGEN(b.x)], 1u);
            asm volatile("s_waitcnt vmcnt(0)" ::: "memory");
        } else {
            XB_SPIN(xb_ld(&bar[XB_XGEN(b.x)]) == gen, bar);
            __builtin_amdgcn_fence(__ATOMIC_ACQUIRE, "agent");
            asm volatile("s_waitcnt vmcnt(0)" ::: "memory");
        }
    }
    __syncthreads();
}
typedef float f32x2 __attribute__((ext_vector_type(2)));
typedef float f32x16 __attribute__((ext_vector_type(16)));
typedef unsigned u32x2 __attribute__((ext_vector_type(2)));
using pg8::pk_bf16;
struct Frame {
    LAS unsigned char* lds;
    volatile LAS unsigned* MISC;
    gu32* ctl;
    int tid, lane, wave;
    int vcu, G;
    const float *x, *pre_g, *post_g, *w_in, *ln_g, *ln_b, *w_s, *b_s, *w_f, *b_f, *w_out; float* out;
    bf16 *WIN, *WOUT, *WSB, *MT, *MTF, *ECS, *H, *UG, *GV, *Z, *SGB, *X1, *A2, *Y;
    float *VSTP, *YSQ;
};
__device__ __forceinline__ float bflo(unsigned w) { return __builtin_bit_cast(float, w << 16); }
__device__ __forceinline__ float bfhi(unsigned w) { return __builtin_bit_cast(float, w & 0xffff0000u); }
__device__ __forceinline__ float wave_sum(float v) {
#pragma unroll
    for (int o = 1; o < 64; o <<= 1) v += __shfl_xor(v, o);
    return v;
}
__device__ __forceinline__ int win_src_col(int n) { const int t = n >> 8, r = n & 255; return t < 4 ? (r < 128 ? t * 128 + r : 1024 + t * 128 + (r - 128)) : (t < 6 ? 512 + (t - 4) * 256 + r : (t < 8 ? 1536 + (t - 6) * 256 + r : 2048 + (t - 8) * 256 + r)); }
__device__ __forceinline__ void p0_transpose_item(const float* W, int K, int N, bf16* WT, const float* kscale, bool remap, LAS float* scr, int item, int lane) {
    const int nblk = N / 32, kb = item / nblk, nb = item % nblk, k0 = 64 * kb, n0 = 32 * nb, s0 = remap ? win_src_col(n0) : n0;
#pragma unroll 8
    for (int i = 0; i < 32; ++i) { const int kk = 2 * i + (lane >> 5); float v = W[(size_t)(k0 + kk) * N + s0 + (lane & 31)]; if (kscale) v *= kscale[k0 + kk]; scr[kk * 33 + (lane & 31)] = v; }
    LDS_WAIT(); asm volatile("" ::: "memory");
    const int c = lane & 7;
#pragma unroll
    for (int j = 0; j < 4; ++j) { const int n = (lane >> 3) + 8 * j; const LAS float* s = scr + (8 * c) * 33 + n;
        v4u o; o.x = pk_bf16(s[0 * 33], s[1 * 33]); o.y = pk_bf16(s[2 * 33], s[3 * 33]); o.z = pk_bf16(s[4 * 33], s[5 * 33]); o.w = pk_bf16(s[6 * 33], s[7 * 33]);
        *(GAS v4u*)(WT + (size_t)(n0 + n) * K + k0 + 8 * c) = o; }
    LDS_WAIT(); asm volatile("" ::: "memory");
}
__device__ __forceinline__ void rms_rows4_to_bf16(Frame& F, const float* xrow, bf16* orow) {
    f32x4 v[4][4]; float s[4];
#pragma unroll
    for (int i = 0; i < 4; ++i) { const GAS f32x4* xr = (const GAS f32x4*)(xrow + (size_t)i * D) + F.lane;
#pragma unroll
        for (int j = 0; j < 4; ++j) v[i][j] = xr[64 * j]; }
#pragma unroll
    for (int i = 0; i < 4; ++i) { s[i] = 0.f;
#pragma unroll
        for (int j = 0; j < 4; ++j) s[i] += (v[i][j].x * v[i][j].x + v[i][j].y * v[i][j].y) + (v[i][j].z * v[i][j].z + v[i][j].w * v[i][j].w); }
#pragma unroll
    for (int o = 1; o < 64; o <<= 1) {
#pragma unroll
        for (int i = 0; i < 4; ++i) s[i] += __shfl_xor(s[i], o); }
#pragma unroll
    for (int i = 0; i < 4; ++i) { const float r = rsqrtf(s[i] * (1.f / D) + EPS); GAS u32x2* o8 = (GAS u32x2*)(orow + (size_t)i * D) + F.lane;
#pragma unroll
        for (int j = 0; j < 4; ++j) o8[64 * j] = (u32x2){pk_bf16(v[i][j].x * r, v[i][j].y * r), pk_bf16(v[i][j].z * r, v[i][j].w * r)}; }
}
__device__ __forceinline__ void p0_prologue(Frame& F) {
    LAS float* scr = (LAS float*)(F.lds + RING_OFF + F.wave * 16384);
    const int gw = F.vcu * NWAVES + F.wave, NGW = F.G * NWAVES;
    constexpr int I_IN = (D / 64) * (DIN / 32), I_OUT = (D / 64) * (D / 32);
    for (int it = gw; it < I_IN + I_OUT; it += NGW) {
        if (it < I_IN) p0_transpose_item(F.w_in, D, DIN, F.WIN, F.pre_g, true, scr, it, F.lane);
        else p0_transpose_item(F.w_out, D, D, F.WOUT, nullptr, false, scr, it - I_IN, F.lane);
    }
    const int gt = gw * 64 + F.lane, NT = NGW * 64;
    for (int i = gt; i < 4 * 128 * 128 / 2; i += NT) { const f32x2 v = *(const f32x2*)(F.w_s + 2 * i); ((unsigned*)F.WSB)[i] = pk_bf16(v.x, v.y); }
    for (int i = gt; i < 16 * 4 * 16 * 64; i += NT) {
        const int ln = i & 63, scs = (i >> 6) & 15, kt = (i >> 10) & 3, k1 = i >> 12, k2 = 32 * kt + (ln & 31), h = ln >> 5, st = scs >> 2, c = (scs >> 1) & 1, s = scs & 1;
        float v[8];
#pragma unroll
        for (int j = 0; j < 8; ++j) { const int sl = 32 * st + 16 * s + 8 * (j >> 2) + 4 * h + (j & 3); const int idx = ((k1 + 16 * k2) * sl) & 2047; float sn, cs; sincospif((float)idx * (1.0f / 1024.0f), &sn, &cs); v[j] = c ? sn : cs; }
        v4u o; o.x = pk_bf16(v[0], v[1]); o.y = pk_bf16(v[2], v[3]); o.z = pk_bf16(v[4], v[5]); o.w = pk_bf16(v[6], v[7]);
        *(v4u*)(F.ECS + (size_t)i * 8) = o;
    }
    {   LAS float* ctab = (LAS float*)(F.lds + RING_OFF + F.wave * 16384 + 12288);
        { float sn, cs; sincospif((float)F.lane * (1.0f / 64.0f), &sn, &cs); ctab[F.lane] = cs; ctab[64 + F.lane] = -cs; }
        LDS_WAIT(); asm volatile("" ::: "memory");
        for (int i = gt; i < 4 * 128 * 128; i += NT) {
            const int c = i & 127, e = (i >> 7) & 127, g = i >> 14; float wc = 0.f, ws = 0.f; const float* wf = F.w_f + (size_t)g * 16384 + e;
#pragma unroll 8
            for (int m = 0; m < 128; ++m) { const int ph = (c * m) & 127; const float w = wf[(size_t)m * 128]; wc += ctab[ph] * w; ws += ctab[(ph + 96) & 127] * w; }
            wc *= (1.0f / 512.0f); ws *= (1.0f / 512.0f);
            unsigned short* mt = (unsigned short*)F.MT + (size_t)g * 65536;
            const unsigned pc = pk_bf16(wc, -ws);
            mt[(size_t)e * 256 + c] = (unsigned short)pc; mt[(size_t)e * 256 + 128 + c] = (unsigned short)(pk_bf16(ws, 0.f));
            mt[(size_t)(128 + e) * 256 + c] = (unsigned short)(pc >> 16); mt[(size_t)(128 + e) * 256 + 128 + c] = (unsigned short)pc;
        }
        LDS_WAIT(); asm volatile("" ::: "memory");
    }
    for (int m = 4 * gw; m < M; m += 4 * NGW) rms_rows4_to_bf16(F, F.x + (size_t)m * D, F.H + (size_t)m * D);
}

__device__ __forceinline__ int lnt_key(int c) { return ((c ^ (c >> 5)) & 1) | (((c >> 3) & 3) << 1) | (((c >> 1) & 1) << 3); }
__device__ __forceinline__ int lnt_off(int c, int qchunk) { return c * 256 + ((qchunk ^ lnt_key(c)) << 4); }
__device__ __forceinline__ void p2_spatial(Frame& F, int ci) {
    LAS unsigned char* lnt = F.lds;
    LAS float* st_mu = (LAS float*)(F.lds + 32768);
    LAS float* st_rs = st_mu + 128;
    const int m0 = ci * 128, tid = F.tid, lane = F.lane, w = F.wave;
    if (tid < 128) {
        const float* sp = F.VSTP + (size_t)(m0 + tid) * 16; float s = 0.f, q = 0.f;
#pragma unroll
        for (int i = 0; i < 8; ++i) { s += sp[2 * i]; q += sp[2 * i + 1]; }
        const float mu = s * (1.f / DA), var = fmaxf(q * (1.f / DA) - mu * mu, 0.f);
        st_mu[tid] = mu; st_rs[tid] = rsqrtf(var + EPS);
    }
    __syncthreads();
    const int cg = lane & 15, tq = lane >> 4, q0 = 16 * w + 4 * tq;
    const int fr = lane & 15, fq = lane >> 4, wcb = (w & 3) * 32, ph = (w >> 2) * 64;
    float mu4[4], rs4[4];
#pragma unroll
    for (int i = 0; i < 4; ++i) { mu4[i] = st_mu[q0 + i]; rs4[i] = st_rs[q0 + i]; }
    for (int h = 0; h < 4; ++h) {
        {
            v4u raw[4];
#pragma unroll
            for (int i = 0; i < 4; ++i) raw[i] = *(const v4u*)(F.GV + (size_t)(m0 + q0 + i) * 512 + h * 128 + 8 * cg);
            const f32x4 g0 = *(const f32x4*)(F.ln_g + h * 128 + 8 * cg), g1 = *(const f32x4*)(F.ln_g + h * 128 + 8 * cg + 4);
            const f32x4 b0 = *(const f32x4*)(F.ln_b + h * 128 + 8 * cg), b1 = *(const f32x4*)(F.ln_b + h * 128 + 8 * cg + 4);
#pragma unroll
            for (int j = 0; j < 8; ++j) {
                const float gg = j < 4 ? g0[j & 3] : g1[j & 3], bb = j < 4 ? b0[j & 3] : b1[j & 3];
                float v[4];
#pragma unroll
                for (int i = 0; i < 4; ++i) { const unsigned wd = raw[i][j >> 1]; const float xv = (j & 1) ? bfhi(wd) : bflo(wd); v[i] = (xv - mu4[i]) * rs4[i] * gg + bb; }
                const int c = 8 * cg + j;
                *(LAS u32x2*)(lnt + lnt_off(c, q0 >> 3) + (q0 & 7) * 2) = (u32x2){pk_bf16(v[0], v[1]), pk_bf16(v[2], v[3])};
            }
        }
        __syncthreads();
        f32x4 acc[2][4];
#pragma unroll
        for (int n = 0; n < 2; ++n)
#pragma unroll
            for (int t = 0; t < 4; ++t) acc[n][t] = (f32x4){0.f, 0.f, 0.f, 0.f};
#pragma unroll
        for (int ks = 0; ks < 4; ++ks) {
            bf16x8 a[2];
#pragma unroll
            for (int n = 0; n < 2; ++n) { const int c = wcb + 8 * (fr >> 2) + 4 * n + (fr & 3); a[n] = *(const LAS bf16x8*)(lnt + lnt_off(c, 4 * ks + fq)); }
#pragma unroll
            for (int t = 0; t < 4; ++t) {
                const bf16x8 bw = *(const bf16x8*)(F.WSB + (size_t)(h * 128 + ph + 16 * t + fr) * 128 + 32 * ks + 8 * fq);
#pragma unroll
                for (int n = 0; n < 2; ++n) acc[n][t] = __builtin_amdgcn_mfma_f32_16x16x32_bf16(a[n], bw, acc[n][t], 0, 0, 0);
            }
        }
#pragma unroll
        for (int t = 0; t < 4; ++t) {
            const int p = ph + 16 * t + fr; const float bs = F.b_s[h * 128 + p];
            const v4u ug = *(const v4u*)(F.UG + (size_t)(m0 + p) * 512 + h * 128 + wcb + 8 * fq);
            v4u o;
            o.x = pk_bf16((acc[0][t][0] + bs) * bflo(ug.x), (acc[0][t][1] + bs) * bfhi(ug.x)); o.y = pk_bf16((acc[0][t][2] + bs) * bflo(ug.y), (acc[0][t][3] + bs) * bfhi(ug.y));
            o.z = pk_bf16((acc[1][t][0] + bs) * bflo(ug.z), (acc[1][t][1] + bs) * bfhi(ug.z)); o.w = pk_bf16((acc[1][t][2] + bs) * bflo(ug.w), (acc[1][t][3] + bs) * bfhi(ug.w));
            *(v4u*)(F.A2 + (size_t)(m0 + p) * 1024 + h * 128 + wcb + 8 * fq) = o;
        }
        __syncthreads();
    }
}
__device__ __forceinline__ void dft16(const float (&z)[16], float (&r)[16]) {
    constexpr float C16[16] = {1.f, 0.92387953251f, 0.70710678119f, 0.38268343237f, 0.f, -0.38268343237f, -0.70710678119f, -0.92387953251f, -1.f, -0.92387953251f, -0.70710678119f, -0.38268343237f, 0.f, 0.38268343237f, 0.70710678119f, 0.92387953251f};
    float e[8], o[8];
#pragma unroll
    for (int s = 1; s < 8; ++s) { e[s] = z[s] + z[16 - s]; o[s] = z[s] - z[16 - s]; }
#pragma unroll
    for (int k = 0; k <= 8; ++k) { float a = (k & 1) ? z[0] - z[8] : z[0] + z[8];
#pragma unroll
        for (int s = 1; s < 8; ++s) a += C16[(k * s) & 15] * e[s];
        r[k] = a; }
#pragma unroll
    for (int k = 1; k < 8; ++k) { float a = 0.f;
#pragma unroll
        for (int s = 1; s < 8; ++s) a -= C16[(k * s + 12) & 15] * o[s];
        r[8 + k] = a; }
}
__device__ __forceinline__ void p2_dft16(Frame& F, int di) {
    const int it = di * 512 + F.tid, cv = it & 63, s_lo = (it >> 6) & 127, b = it >> 13;
#pragma unroll 1
    for (int hf = 0; hf < 2; ++hf) {
        const bf16* zp = F.Z + ((size_t)(b * 2048 + s_lo)) * 512 + 8 * cv + 4 * hf;
        u32x2 in[16];
#pragma unroll
        for (int s = 0; s < 16; ++s) in[s] = *(const u32x2*)(zp + (size_t)s * 128 * 512);
        u32x2 outp[16];
#pragma unroll
        for (int jp = 0; jp < 2; ++jp) {
            float zl[16], zh[16], rl[16], rh[16];
#pragma unroll
            for (int s = 0; s < 16; ++s) { zl[s] = bflo(in[s][jp]); zh[s] = bfhi(in[s][jp]); }
            dft16(zl, rl); dft16(zh, rh);
#pragma unroll
            for (int pl = 0; pl < 16; ++pl) outp[pl][jp] = pk_bf16(rl[pl], rh[pl]);
        }
        bf16* xp = F.X1 + ((size_t)(b * 16) * 128 + s_lo) * 512 + 8 * cv + 4 * hf;
#pragma unroll
        for (int pl = 0; pl < 16; ++pl) *(u32x2*)(xp + (size_t)pl * 128 * 512) = outp[pl];
    }
}
__device__ __forceinline__ v4u pack8(const f32x16& x, int s) { v4u p; p.x = pk_bf16(x[8 * s], x[8 * s + 1]); p.y = pk_bf16(x[8 * s + 2], x[8 * s + 3]); p.z = pk_bf16(x[8 * s + 4], x[8 * s + 5]); p.w = pk_bf16(x[8 * s + 6], x[8 * s + 7]); return p; }
__device__ __forceinline__ void p3_unit_decode(int ui, int& b, int& k1) { b = ui >> 4; const int j = ui & 15; k1 = j < 8 ? j : (j == 8 ? 8 : 24 - j); }
__device__ __forceinline__ void p2_mtf(Frame& F) {
    const int gt = (F.vcu * NWAVES + F.wave) * 64 + F.lane, NT = F.G * NWAVES * 64;
    for (int i2 = gt; i2 < 2 * 32768; i2 += NT) { const int i = i2 & 32767, ln = i & 63, ks = (i >> 6) & 15, et = (i >> 10) & 3, c = (i >> 12) & 1, g = i >> 13;
        v4u t = *(const v4u*)(F.MT + ((size_t)(g * 256 + c * 128 + et * 32 + (ln & 31))) * 256 + 16 * ks + 8 * (ln >> 5));
        const unsigned fl = (i2 >= 32768 && ks >= 8) ? 0x80008000u : 0u; t.x ^= fl; t.y ^= fl; t.z ^= fl; t.w ^= fl;
        *(v4u*)(F.MTF + (size_t)i2 * 8) = t; }
}
__device__ __forceinline__ void p3_slab_dma(Frame& F, LAS unsigned char* slab, int b, int k1, int g) {
    const int k1p = k1 <= 8 ? k1 : 16 - k1; const bool has_im = (k1p != 0 && k1p != 8);
    const bf16* xr = F.X1 + ((size_t)(b * 16 + k1p) * 128) * 512 + g * 128; const bf16* xi = has_im ? F.X1 + ((size_t)(b * 16 + 8 + k1p) * 128) * 512 + g * 128 : xr;
    int ln = F.lane; asm volatile("" : "+v"(ln));
#pragma unroll
    for (int i = 0; i < 8; ++i) { const int pc = i * 8 + F.wave, row = 2 * pc + (ln >> 5), c = (ln & 31) ^ (row & 15);
        const bf16* src = (c >= 16 ? xi : xr) + (size_t)row * 512 + (c & 15) * 8;
        __builtin_amdgcn_global_load_lds((const unsigned*)src, (LAS unsigned*)(slab + pc * 1024), 16, 0, 0); }
}
__device__ __forceinline__ void p3_fourier_all(Frame& F) {
    LAS unsigned char* slab = F.lds; LAS unsigned char* xb = F.lds + 65536;
    const int lane = F.lane, w = F.wave, r = lane & 31, hh = lane >> 5;
    const int et1 = w & 3, c1 = w >> 2;
    const int kt2 = w & 3, eh2 = w >> 2;
    bf16x8 bm[16];
#define P3_LDBM16(gg, cj) do { _Pragma("unroll") for (int q_ = 0; q_ < 16; ++q_) bm[q_] = *(const bf16x8*)(F.MTF + (size_t)(cj) * 262144 + ((((size_t)(gg) * 2 + c1) * 4 + et1) * 16 + q_) * 512 + lane * 8); } while (0)
    bool first = true;
#pragma unroll 1
    for (int ui = blockIdx.x; ui < 512; ui += F.G) {
        int b, k1; p3_unit_decode(ui, b, k1);
        const int k1p = k1 <= 8 ? k1 : 16 - k1; const bool has_im = (k1p != 0 && k1p != 8);
        bf16x8 Ef[16];
#pragma unroll
        for (int scs = 0; scs < 16; ++scs) Ef[scs] = *(const bf16x8*)(F.ECS + ((((size_t)k1 * 4 + kt2) * 16 + scs) * 64 + lane) * 8);
        if (first) { p3_slab_dma(F, slab, b, k1, 0); P3_LDBM16(0, k1 > 8 ? 1 : 0); asm volatile("s_waitcnt vmcnt(0)" ::: "memory"); __syncthreads(); first = false; }
        const int k2 = 32 * kt2 + r;
#pragma unroll 1
        for (int g = 0; g < 4; ++g) {
#pragma unroll
            for (int pass = 0; pass < 2; ++pass) {
                f32x16 Dt[2];
#pragma unroll
                for (int a = 0; a < 2; ++a)
#pragma unroll
                    for (int i = 0; i < 16; ++i) Dt[a][i] = 0.f;
#pragma unroll
                for (int ks = 0; ks < 16; ++ks) {
                    if (ks < 8 || has_im) {
#pragma unroll
                        for (int sti = 0; sti < 2; ++sti) { const int row = 32 * (2 * pass + sti) + r; const bf16x8 ax = *(const LAS bf16x8*)(slab + row * 512 + (((2 * ks + hh) ^ (row & 15)) << 4));
                            Dt[sti] = __builtin_amdgcn_mfma_f32_32x32x16_bf16(ax, bm[ks], Dt[sti], 0, 0, 0); }
                    }
                }
#pragma unroll
                for (int sti = 0; sti < 2; ++sti)
#pragma unroll
                    for (int s = 0; s < 2; ++s) *(LAS v4u*)(xb + (((((2 * pass + sti) * 2 + c1) * 2 + s) * 4 + et1) << 10) + lane * 16) = pack8(Dt[sti], s);
            }
            __syncthreads();
            const bool nxt_unit = (g == 3), has_next = !nxt_unit || (ui + F.G < 512);
            if (has_next) { int nb = b, nk1 = k1; if (nxt_unit) p3_unit_decode(ui + F.G, nb, nk1); p3_slab_dma(F, slab, nb, nk1, nxt_unit ? 0 : g + 1); }
            f32x16 Yt[2];
#pragma unroll
            for (int a = 0; a < 2; ++a)
#pragma unroll
                for (int i = 0; i < 16; ++i) Yt[a][i] = 0.f;
#pragma unroll
            for (int scs = 0; scs < 16; ++scs)
#pragma unroll
                for (int eti = 0; eti < 2; ++eti) { const bf16x8 df = *(const LAS bf16x8*)(xb + ((scs * 4 + 2 * eh2 + eti) << 10) + lane * 16);
                    Yt[eti] = __builtin_amdgcn_mfma_f32_32x32x16_bf16(df, Ef[scs], Yt[eti], 0, 0, 0); }
            int tidl = F.tid; asm volatile("" : "+v"(tidl));
            v4u sgq[4];
#pragma unroll
            for (int i = 0; i < 4; ++i) { const int cidx = i * 512 + tidl, rw = cidx >> 4, ch = cidx & 15; sgq[i] = *(const v4u*)(F.SGB + ((size_t)b * 2048 + k1 + 16 * rw) * 512 + g * 128 + ch * 8); }
            __syncthreads();
#pragma unroll
            for (int eti = 0; eti < 2; ++eti)
#pragma unroll
                for (int qd = 0; qd < 4; ++qd) { const int el = (2 * eh2 + eti) * 32 + 8 * qd + 4 * hh; const f32x4 bias = *(const f32x4*)(F.b_f + g * 128 + el);
                    const u32x2 o = {pk_bf16(Yt[eti][4 * qd + 0] + bias[0], Yt[eti][4 * qd + 1] + bias[1]), pk_bf16(Yt[eti][4 * qd + 2] + bias[2], Yt[eti][4 * qd + 3] + bias[3])};
                    *(LAS u32x2*)(xb + k2 * 256 + ((((el >> 3) ^ (k2 & 15)) << 4) | (hh << 3))) = o; }
            if (has_next) { int nb = b, nk1 = k1; if (nxt_unit) p3_unit_decode(ui + F.G, nb, nk1); P3_LDBM16(nxt_unit ? 0 : g + 1, nk1 > 8 ? 1 : 0); }
            __syncthreads();
#pragma unroll
            for (int i = 0; i < 4; ++i) { const int cidx = i * 512 + tidl, rw = cidx >> 4, ch = cidx & 15;
                const v4u yv = *(const LAS v4u*)(xb + rw * 256 + ((ch ^ (rw & 15)) << 4)); const v4u sv = sgq[i];
                v4u o; o.x = pk_bf16(bflo(yv.x) * bflo(sv.x), bfhi(yv.x) * bfhi(sv.x)); o.y = pk_bf16(bflo(yv.y) * bflo(sv.y), bfhi(yv.y) * bfhi(sv.y));
                o.z = pk_bf16(bflo(yv.z) * bflo(sv.z), bfhi(yv.z) * bfhi(sv.z)); o.w = pk_bf16(bflo(yv.w) * bflo(sv.w), bfhi(yv.w) * bfhi(sv.w));
                *(v4u*)(F.A2 + ((size_t)b * 2048 + k1 + 16 * rw) * 1024 + 512 + g * 128 + ch * 8) = o; }
            asm volatile("s_waitcnt vmcnt(0)" ::: "memory");
            __syncthreads();
        }
    }
#undef P3_LDBM16
}
__device__ __forceinline__ void p5_final_rows(Frame& F, int row0, int nrows) {
    const int lane = F.lane;
    f32x4 pg[4];
#pragma unroll
    for (int j = 0; j < 4; ++j) pg[j] = *(const f32x4*)(F.post_g + 4 * lane + 256 * j);
    for (int mb = row0 + 4 * F.wave; mb < row0 + nrows; mb += 4 * NWAVES) {
        float qv = F.YSQ[(size_t)mb * 16 + lane];
        u32x2 y[4][4]; f32x4 xv[4][4];
#pragma unroll
        for (int i = 0; i < 4; ++i) {
#pragma unroll
            for (int j = 0; j < 4; ++j) { y[i][j] = *(const u32x2*)(F.Y + (size_t)(mb + i) * D + 4 * lane + 256 * j); xv[i][j] = *(const f32x4*)(F.x + (size_t)(mb + i) * D + 4 * lane + 256 * j); } }
        qv += __shfl_xor(qv, 1); qv += __shfl_xor(qv, 2); qv += __shfl_xor(qv, 4); qv += __shfl_xor(qv, 8);
#pragma unroll
        for (int i = 0; i < 4; ++i) {
            const float rstd = rsqrtf(__shfl(qv, 16 * i) * (1.f / D) + EPS);
#pragma unroll
            for (int j = 0; j < 4; ++j) { const unsigned w0 = y[i][j].x, w1 = y[i][j].y;
                f32x4 o; o.x = xv[i][j].x + bflo(w0) * rstd * pg[j].x; o.y = xv[i][j].y + bfhi(w0) * rstd * pg[j].y; o.z = xv[i][j].z + bflo(w1) * rstd * pg[j].z; o.w = xv[i][j].w + bfhi(w1) * rstd * pg[j].w;
                *(f32x4*)(F.out + (size_t)(mb + i) * D + 4 * lane + 256 * j) = o; }
        }
    }
}

struct Args { const float* in[11]; float* out; unsigned char* ws; int ph_lo, ph_hi, li, pad; };
__global__ void __launch_bounds__(NWAVES * 64, 2) mega_fwd(Args args) {
    extern __shared__ __attribute__((aligned(16))) unsigned char lds[];
    Frame F;
    F.lds = (LAS unsigned char*)lds;
    F.MISC = (volatile LAS unsigned*)(F.lds + MISC_OFF);
    F.tid = threadIdx.x; F.lane = F.tid & 63; F.wave = __builtin_amdgcn_readfirstlane(F.tid >> 6);
    F.G = gridDim.x; { const int bx = blockIdx.x; F.vcu = (F.G % 8 == 0) ? (bx % 8) * (F.G / 8) + bx / 8 : bx; }
    unsigned char* ws = args.ws;
    F.ctl = (gu32*)(ws + WS_CTL);
    F.x = args.in[0]; F.pre_g = args.in[1]; F.post_g = args.in[2]; F.w_in = args.in[3]; F.ln_g = args.in[4]; F.ln_b = args.in[5]; F.w_s = args.in[6]; F.b_s = args.in[7];
    F.w_f = args.in[8]; F.b_f = args.in[9]; F.w_out = args.in[10]; F.out = args.out;
    F.WIN = (bf16*)(ws + WS_WIN); F.WOUT = (bf16*)(ws + WS_WOUT); F.WSB = (bf16*)(ws + WS_WSB); F.MT = (bf16*)(ws + WS_MT); F.MTF = (bf16*)(ws + WS_MTF); F.ECS = (bf16*)(ws + WS_ECS);
    F.H = (bf16*)(ws + WS_H); F.UG = (bf16*)(ws + WS_UG); F.GV = (bf16*)(ws + WS_GV); F.Z = (bf16*)(ws + WS_Z); F.SGB = (bf16*)(ws + WS_SGB); F.X1 = (bf16*)(ws + WS_X1);
    F.A2 = (bf16*)(ws + WS_A2); F.Y = (bf16*)(ws + WS_Y); F.VSTP = (float*)(ws + WS_VSTP); F.YSQ = (float*)(ws + WS_YSQ);
    for (int u = F.tid; u < (LDS_BYTES - LDSCTL_OFF) / 4; u += NWAVES * 64) ((LAS unsigned*)(F.lds + LDSCTL_OFF))[u] = 0u;
    __syncthreads();
    XcdBarrier bar; bar.bar = (unsigned*)(F.ctl + CW_BAR); bar.x = 0; bar.st = nullptr;
    if (N_LAUNCHES != PER_PHASE) bar = xcd_barrier_post((unsigned*)(F.ctl + CW_BAR), F.MISC + 8);
#define GRID_BAR() do { if (N_LAUNCHES != PER_PHASE) xcd_barrier(bar); } while (0)
    const int lo = args.ph_lo, hi = args.ph_hi;
#define IN(k) (lo <= (k) && (k) < hi)
#define BOTH(k) (IN(k) && IN((k) + 1))
    if (IN(0)) { p0_prologue(F); if (BOTH(0)) GRID_BAR(); }
    if (IN(1)) {
        pg8::Gemm g{F.H, F.WIN, M, DIN, D}; pg8::StaticOrder S; S.init(M, DIN, F.G, (int)blockIdx.x);
        pg8::EpiIn E{F.UG, F.GV, F.Z, F.SGB, F.VSTP};
        pg8::gemm_phase<pg8::EpiIn, pg8::StaticOrder, true, true>(F.lds + RING_OFF, g, S, E);
        if (BOTH(1)) GRID_BAR();
    }
    if (IN(2)) {
        p2_mtf(F);
        for (int i = blockIdx.x; i < 1024; i += F.G) { if (i < 512) p2_spatial(F, i); else p2_dft16(F, i - 512); }
        if (BOTH(2)) GRID_BAR();
    }
    if (IN(3)) {
        p3_fourier_all(F);
        if (BOTH(3)) GRID_BAR();
    }
    if (IN(4)) {
        pg8::Gemm g{F.A2, F.WOUT, M, D, D}; pg8::PanelOrder S{F.G, F.vcu, M / 256, D / 256};
        pg8::EpiY E{F.Y, F.YSQ};
        pg8::gemm_phase<pg8::EpiY, pg8::PanelOrder, true, true>(F.lds + RING_OFF, g, S, E);
        __builtin_amdgcn_fence(__ATOMIC_ACQUIRE, "agent");
        for (int pm = F.vcu; pm < M / 256; pm += F.G) p5_final_rows(F, pm * 256, 256);
    }
#undef IN
#undef BOTH
}

extern "C" void kernel_launch(void* const* d_in, const int* in_sizes, int n_in, void* d_out, int out_size, void* d_ws, size_t ws_size, hipStream_t stream) {
    static int grid = 0;
    if (grid == 0) {
        if (n_in != 11 || in_sizes[0] != M * D || out_size != M * D || ws_size < WS_END) { fprintf(stderr, "kernel_launch: unexpected shapes / workspace (n_in %d, in0 %d, out %d, ws %zu)\n", n_in, n_in > 0 ? in_sizes[0] : -1, out_size, ws_size); grid = -1; return; }
        int dev = 0, cus = 0, per_cu = 0;
        if (hipGetDevice(&dev) != hipSuccess || hipDeviceGetAttribute(&cus, hipDeviceAttributeMultiprocessorCount, dev) != hipSuccess) { grid = -1; return; }
        if (hipFuncSetAttribute((const void*)mega_fwd, hipFuncAttributeMaxDynamicSharedMemorySize, LDS_BYTES) != hipSuccess) { fprintf(stderr, "kernel_launch: hipFuncSetAttribute failed\n"); grid = -1; return; }
        if (hipOccupancyMaxActiveBlocksPerMultiprocessor(&per_cu, (const void*)mega_fwd, NWAVES * 64, LDS_BYTES) != hipSuccess || per_cu < 1) { fprintf(stderr, "kernel_launch: occupancy query says %d blocks per CU\n", per_cu); (void)hipGetLastError(); per_cu = 1; }
        grid = cus;
    }
    if (grid < 0) return;
    (void)hipMemsetAsync((char*)d_ws + WS_CTL, 0, CTL_ZERO_BYTES, stream);
    Args a; memset(&a, 0, sizeof(a));
    for (int i = 0; i < 11; ++i) a.in[i] = (const float*)d_in[i];
    a.out = (float*)d_out; a.ws = (unsigned char*)d_ws;
    for (int li = 0; li < N_LAUNCHES; ++li) {
        a.ph_lo = (N_LAUNCHES == PER_PHASE) ? li : 0; a.ph_hi = (N_LAUNCHES == PER_PHASE) ? li + 1 : PER_PHASE; a.li = li;
        hipLaunchKernelGGL(mega_fwd, dim3(grid), dim3(NWAVES * 64), LDS_BYTES, stream, a);
    }
    if (PROBE_REPEAT >= 0) { a.ph_lo = PROBE_REPEAT; a.ph_hi = PROBE_REPEAT + 1; a.li = 1; hipLaunchKernelGGL(mega_fwd, dim3(grid), dim3(NWAVES * 64), LDS_BYTES, stream, a); }
}
```

```cpp
#include <hip/hip_runtime.h>
#include <cstdio>
#include <cstdint>
#include <cstring>

namespace pg8 {
#define PG8_LAS __attribute__((address_space(3)))
typedef unsigned short bf16_t;
typedef short bf16x8 __attribute__((ext_vector_type(8)));
typedef float f32x4 __attribute__((ext_vector_type(4)));
typedef unsigned u32x4 __attribute__((ext_vector_type(4)));
constexpr int BM = 256, BK = 64, HALF = 128, HTB = HALF * BK * 2  , STAGE_BYTES = 8 * HTB, NXCD = 8, WGM = 8;

__host__ __device__ __forceinline__ int lds_byte(int r, int c) { const int st = (r >> 4) * 2 + (c >> 5), rr = r & 15, cc = c & 31, ob = rr * 64 + cc * 2; return st * 1024 + (ob ^ (((ob >> 9) & 1) << 5)); }
__host__ __device__ __forceinline__ void stage_rc(int b, int& R, int& C) { const int st = b / 1024, sb = b % 1024, swz = sb ^ (((sb >> 9) & 1) << 5); R = (st >> 1) * 16 + swz / 64; C = (st & 1) * 32 + (swz % 64) / 2; }
__host__ __device__ __forceinline__ int perm32(int rho) { const int n = rho >> 4, i = rho & 15; return 8 * (i >> 2) + 4 * n + (i & 3); }

struct Unit { int pm, pn; };
struct Gemm { const bf16_t* A; const bf16_t* Bt; int M, N, K; };

struct StaticOrder {
    int nM, nN, nwg, G, c;
    __host__ __device__ void init(int M, int N, int G_, int c_) { nM = M / BM; nN = N / BM; nwg = nM * nN; G = G_; c = c_; }
    __host__ __device__ bool next(int i, Unit& u) const {
        const long L = (long)i * G + c; if (L >= nwg) return false;
        int wgid = (int)L; { const int q = nwg / NXCD, r = nwg % NXCD, xcd = wgid % NXCD, off = wgid / NXCD; wgid = (xcd < r ? xcd * (q + 1) : r * (q + 1) + (xcd - r) * q) + off; }
        const int nig = WGM * nN, gid = wgid / nig, fm = gid * WGM, gsz = (nM - fm) < WGM ? (nM - fm) : WGM;
        u.pm = fm + ((wgid % nig) % gsz); u.pn = (wgid % nig) / gsz; return true;
    }
    __device__ __forceinline__ void a_ready(const Unit&) const {}
    __device__ __forceinline__ void done(const Unit&) const {}
};

typedef float f32x2 __attribute__((ext_vector_type(2)));
__device__ __forceinline__ f32x2 gelu_pk(f32x2 v) {
    const f32x2 av = __builtin_elementwise_abs(v), d = av * 0.2316418882f + 1.0f;
    f32x2 t; t.x = __builtin_amdgcn_rcpf(d.x); t.y = __builtin_amdgcn_rcpf(d.y);
    f32x2 q = t * 0.5307027145f + (-0.7265760135f); q = q * t + 0.7107068705f; q = q * t + (-0.142248368f); q = q * t + 0.127414796f; q = q * t;
    const f32x2 s = (v * v) * (-0.72134752044f);
    f32x2 e; e.x = __builtin_amdgcn_exp2f(s.x); e.y = __builtin_amdgcn_exp2f(s.y);
    const f32x2 m = v * (q * e), r = v - m;
    f32x2 o; o.x = v.x < 0.f ? m.x : r.x; o.y = v.y < 0.f ? m.y : r.y; return o;
}
typedef __bf16 bf16x2_t __attribute__((ext_vector_type(2)));
__device__ __forceinline__ unsigned pk_bf16(float lo, float hi) { const f32x2 f = {lo, hi}; return __builtin_bit_cast(unsigned, __builtin_convertvector(f, bf16x2_t)); }
__device__ __forceinline__ float silu_f(float v) { return v * __builtin_amdgcn_rcpf(1.0f + __builtin_amdgcn_exp2f(-1.44269504089f * v)); }
struct EpiIn {
    static constexpr bool PERM = true, AFTER_DRAIN = false;
    bf16_t *UG, *GV, *Z, *SGB; float* VSTP;
    __device__ __forceinline__ void operator()(const f32x4 (&acc)[2][2][4][2], const Unit& u, int wr, int wc, int fr, int fq) const {
        const int row0 = u.pm * BM + wr * 64 + fr, cl = wc * 32 + 8 * fq;
        if (u.pn < 4) {
            bf16_t* base = UG + (size_t)row0 * 512 + u.pn * 128 + cl;
#pragma unroll
            for (int ai = 0; ai < 2; ++ai)
#pragma unroll
                for (int m = 0; m < 4; ++m) {
                    const f32x4 a0 = acc[ai][0][m][0], a1 = acc[ai][0][m][1], g0 = acc[ai][1][m][0], g1 = acc[ai][1][m][1];
                    const f32x2 p0 = gelu_pk((f32x2){a0[0], a0[1]}), p1 = gelu_pk((f32x2){a0[2], a0[3]}), p2 = gelu_pk((f32x2){a1[0], a1[1]}), p3 = gelu_pk((f32x2){a1[2], a1[3]});
                    u32x4 w;
                    w.x = pk_bf16(p0.x * silu_f(g0[0]), p0.y * silu_f(g0[1])); w.y = pk_bf16(p1.x * silu_f(g0[2]), p1.y * silu_f(g0[3]));
                    w.z = pk_bf16(p2.x * silu_f(g1[0]), p2.y * silu_f(g1[1])); w.w = pk_bf16(p3.x * silu_f(g1[2]), p3.y * silu_f(g1[3]));
                    *(u32x4*)(base + (size_t)(ai * HALF + m * 16) * 512) = w;
                }
        } else if (u.pn < 6) {
            bf16_t* base = GV + (size_t)row0 * 512 + (u.pn - 4) * 256 + cl;
            float* sp = VSTP + (size_t)row0 * 16 + ((u.pn - 4) * 4 + wc) * 2;
#pragma unroll
            for (int ai = 0; ai < 2; ++ai)
#pragma unroll
                for (int m = 0; m < 4; ++m) {
                    float s = 0.f, q = 0.f;
#pragma unroll
                    for (int bj = 0; bj < 2; ++bj) {
                        const f32x4 a0 = acc[ai][bj][m][0], a1 = acc[ai][bj][m][1];
                        const f32x2 p0 = gelu_pk((f32x2){a0[0], a0[1]}), p1 = gelu_pk((f32x2){a0[2], a0[3]}), p2 = gelu_pk((f32x2){a1[0], a1[1]}), p3 = gelu_pk((f32x2){a1[2], a1[3]});
                        s += ((p0.x + p0.y) + (p1.x + p1.y)) + ((p2.x + p2.y) + (p3.x + p3.y));
                        q += ((p0.x * p0.x + p0.y * p0.y) + (p1.x * p1.x + p1.y * p1.y)) + ((p2.x * p2.x + p2.y * p2.y) + (p3.x * p3.x + p3.y * p3.y));
                        u32x4 w; w.x = pk_bf16(p0.x, p0.y); w.y = pk_bf16(p1.x, p1.y); w.z = pk_bf16(p2.x, p2.y); w.w = pk_bf16(p3.x, p3.y);
                        *(u32x4*)(base + (size_t)(ai * HALF + m * 16) * 512 + bj * HALF) = w;
                    }
                    s += __shfl_xor(s, 16); s += __shfl_xor(s, 32); q += __shfl_xor(q, 16); q += __shfl_xor(q, 32);
                    if (fq == 0) *(f32x2*)(sp + (size_t)(ai * HALF + m * 16) * 16) = (f32x2){s, q};
                }
        } else {
            const bool act = u.pn >= 8;
            bf16_t* base = (act ? SGB + (size_t)(u.pn - 8) * 256 : Z + (size_t)(u.pn - 6) * 256) + (size_t)row0 * 512 + cl;
#pragma unroll
            for (int ai = 0; ai < 2; ++ai)
#pragma unroll
                for (int m = 0; m < 4; ++m)
#pragma unroll
                    for (int bj = 0; bj < 2; ++bj) {
                        f32x4 a0 = acc[ai][bj][m][0], a1 = acc[ai][bj][m][1];
                        if (act) { a0 = (f32x4){silu_f(a0[0]), silu_f(a0[1]), silu_f(a0[2]), silu_f(a0[3])}; a1 = (f32x4){silu_f(a1[0]), silu_f(a1[1]), silu_f(a1[2]), silu_f(a1[3])}; }
                        u32x4 w; w.x = pk_bf16(a0[0], a0[1]); w.y = pk_bf16(a0[2], a0[3]); w.z = pk_bf16(a1[0], a1[1]); w.w = pk_bf16(a1[2], a1[3]);
                        *(u32x4*)(base + (size_t)(ai * HALF + m * 16) * 512 + bj * HALF) = w;
                    }
        }
    }
};
struct EpiY {
    static constexpr bool PERM = true, AFTER_DRAIN = false;
    bf16_t* Y; float* YSQ;
    __device__ __forceinline__ void operator()(const f32x4 (&acc)[2][2][4][2], const Unit& u, int wr, int wc, int fr, int fq) const {
        const int row0 = u.pm * BM + wr * 64 + fr, cl = wc * 32 + 8 * fq;
        bf16_t* base = Y + (size_t)row0 * 1024 + u.pn * 256 + cl;
        float* sp = YSQ + (size_t)row0 * 16 + u.pn * 4 + wc;
#pragma unroll
        for (int ai = 0; ai < 2; ++ai)
#pragma unroll
            for (int m = 0; m < 4; ++m) {
                float q = 0.f;
#pragma unroll
                for (int bj = 0; bj < 2; ++bj) {
                    const f32x4 a0 = acc[ai][bj][m][0], a1 = acc[ai][bj][m][1];
                    q += ((a0[0] * a0[0] + a0[1] * a0[1]) + (a0[2] * a0[2] + a0[3] * a0[3])) + ((a1[0] * a1[0] + a1[1] * a1[1]) + (a1[2] * a1[2] + a1[3] * a1[3]));
                    u32x4 w; w.x = pk_bf16(a0[0], a0[1]); w.y = pk_bf16(a0[2], a0[3]); w.z = pk_bf16(a1[0], a1[1]); w.w = pk_bf16(a1[2], a1[3]);
                    *(u32x4*)(base + (size_t)(ai * HALF + m * 16) * 1024 + bj * HALF) = w;
                }
                q += __shfl_xor(q, 16); q += __shfl_xor(q, 32);
                if (fq == 0) sp[(size_t)(ai * HALF + m * 16) * 16] = q;
            }
    }
};
struct PanelOrder {
    int G, c, nM, nN;
    __device__ __forceinline__ bool next(int i, Unit& u) const { const int pm = c + G * (i / nN); if (pm >= nM) return false; u.pm = pm; u.pn = i % nN; return true; }
    __device__ __forceinline__ void a_ready(const Unit&) const {}
    __device__ __forceinline__ void done(const Unit&) const {}
};


template <class Epi, class Sched, bool ALIGN_EPI = false, bool SP2 = false>
__device__ __forceinline__ void gemm_phase(PG8_LAS unsigned char* lds, const Gemm g, const Sched& S, const Epi& E) {
    const int tid = threadIdx.x, wid = __builtin_amdgcn_readfirstlane(tid >> 6), lane = tid & 63, wr = wid >> 2, wc = wid & 3, fr = lane & 15, fq = lane >> 4;
    const int K = g.K, nt = K / BK;
    unsigned voffA[2], voffB[2];
#pragma unroll
    for (int i = 0; i < 2; ++i) { int R, C; stage_rc(tid * 16 + i * 8192, R, C); const int Rb = Epi::PERM ? ((R & ~31) + perm32(R & 31)) : R;
        voffA[i] = (unsigned)(R * K + C) * 2u; voffB[i] = (unsigned)(Rb * K + C) * 2u; }
    const size_t kstep = (size_t)(BK * 2);
    const size_t hstep = (size_t)HALF * K * 2;
    const size_t tstep = 2 * hstep;
    const unsigned ldsw = (unsigned)wid * 1024u;
    const int aoff = lds_byte(wr * 64 + fr, fq * 8), boff = lds_byte(wc * 32 + fr, fq * 8);
#define PG8_SA(b, h) (((b) * 2 + (h)) * HTB)
#define PG8_SB(b, h) ((4 + (b) * 2 + (h)) * HTB)
#define PG8_STAGE(bufoff, gbase, voff) do { _Pragma("unroll") for (int _i = 0; _i < 2; ++_i) \
        __builtin_amdgcn_global_load_lds((const unsigned*)((const char*)(gbase) + (voff)[_i]), (PG8_LAS unsigned*)(lds + (bufoff) + ldsw + _i * 8192), 16, 0, 0); } while (0)
#define PG8_LDA(dst, b, h) do { _Pragma("unroll") for (int m = 0; m < 4; ++m) _Pragma("unroll") for (int k = 0; k < 2; ++k) dst[m][k] = *(const PG8_LAS bf16x8*)(lds + PG8_SA(b, h) + aoff + m * 2048 + k * 1024); } while (0)
#define PG8_LDB(dst, b, h) do { _Pragma("unroll") for (int n = 0; n < 2; ++n) _Pragma("unroll") for (int k = 0; k < 2; ++k) dst[n][k] = *(const PG8_LAS bf16x8*)(lds + PG8_SB(b, h) + boff + n * 2048 + k * 1024); } while (0)
#define PG8_MMA(ai, bj, At, Bt) do { __builtin_amdgcn_s_setprio(1); _Pragma("unroll") for (int m = 0; m < 4; ++m) _Pragma("unroll") for (int n = 0; n < 2; ++n) _Pragma("unroll") for (int k = 0; k < 2; ++k) \
        acc[ai][bj][m][n] = __builtin_amdgcn_mfma_f32_16x16x32_bf16(Bt[n][k], At[m][k], acc[ai][bj][m][n], 0, 0, 0); __builtin_amdgcn_s_setprio(0); } while (0)
#define PG8_WAIT_V(n) asm volatile("s_waitcnt vmcnt(" #n ")" ::: "memory")
#define PG8_WAIT_L(n) asm volatile("s_waitcnt lgkmcnt(" #n ")" ::: "memory")
#define PG8_BAR __builtin_amdgcn_s_barrier()
#define PG8_SCHED __builtin_amdgcn_sched_barrier(0)
    Unit cur, nxt; int ui = 0;
    if (!S.next(0, cur)) return;
    f32x4 acc[2][2][4][2];
#pragma unroll
    for (int a = 0; a < 2; ++a)
#pragma unroll
        for (int b = 0; b < 2; ++b)
#pragma unroll
            for (int m = 0; m < 4; ++m)
#pragma unroll
                for (int n = 0; n < 2; ++n) acc[a][b][m][n] = (f32x4){0.f, 0.f, 0.f, 0.f};
    bf16x8 At[4][2], B0[2][2], B1[2][2];
    const char* cA = (const char*)g.A + (size_t)cur.pm * tstep; const char* cB = (const char*)g.Bt + (size_t)cur.pn * tstep;
    S.a_ready(cur);
    if constexpr (SP2) {
        PG8_STAGE(PG8_SB(0, 0), cB, voffB); PG8_STAGE(PG8_SB(0, 1), cB + hstep, voffB); PG8_STAGE(PG8_SA(0, 0), cA, voffA); PG8_STAGE(PG8_SA(0, 1), cA + hstep, voffA);
        if (wr == 1) PG8_BAR;
        PG8_WAIT_V(2); PG8_BAR;
        PG8_STAGE(PG8_SB(1, 0), cB + kstep, voffB); PG8_STAGE(PG8_SA(1, 0), cA + kstep, voffA); PG8_STAGE(PG8_SB(1, 1), cB + hstep + kstep, voffB);
        PG8_WAIT_V(6); PG8_BAR;
    } else {
        PG8_STAGE(PG8_SB(0, 0), cB, voffB); PG8_STAGE(PG8_SA(0, 0), cA, voffA); PG8_STAGE(PG8_SB(0, 1), cB + hstep, voffB); PG8_STAGE(PG8_SA(0, 1), cA + hstep, voffA);
        if (wr == 1) PG8_BAR;
        PG8_WAIT_V(4); PG8_BAR;
        PG8_STAGE(PG8_SB(1, 0), cB + kstep, voffB); PG8_STAGE(PG8_SA(1, 0), cA + kstep, voffA); PG8_STAGE(PG8_SB(1, 1), cB + hstep + kstep, voffB);
        PG8_WAIT_V(6); PG8_BAR;
    }
    for (;;) {
        const bool has_next = S.next(ui + 1, nxt);
        const char* nA = has_next ? (const char*)g.A + (size_t)nxt.pm * tstep : cA; const char* nB = has_next ? (const char*)g.Bt + (size_t)nxt.pn * tstep : cB;
        for (int t = 0; t < nt; t += 2) {
            const bool last = (t == nt - 2);
            const char* a1 = cA + (size_t)(t + 1) * kstep;
            const char* a2 = last ? nA : cA + (size_t)(t + 2) * kstep; const char* b2 = last ? nB : cB + (size_t)(t + 2) * kstep;
            const char* a3 = a2 + kstep; const char* b3 = b2 + kstep;
            if (last && has_next) S.a_ready(nxt);
            if constexpr (SP2) {
            PG8_LDB(B0, 0, 0); PG8_LDB(B1, 0, 1); PG8_SCHED; PG8_LDA(At, 0, 0); PG8_STAGE(PG8_SA(1, 1), a1 + hstep, voffA);
            PG8_WAIT_V(8); PG8_WAIT_L(0); PG8_BAR; PG8_MMA(0, 0, At, B0); PG8_MMA(0, 1, At, B1); PG8_BAR; PG8_SCHED;
            PG8_LDA(At, 0, 1); PG8_STAGE(PG8_SB(0, 0), b2, voffB); PG8_STAGE(PG8_SB(0, 1), b2 + hstep, voffB); PG8_STAGE(PG8_SA(0, 0), a2, voffA);
            PG8_WAIT_V(8); PG8_WAIT_L(0); PG8_BAR; PG8_MMA(1, 0, At, B0); PG8_MMA(1, 1, At, B1); PG8_BAR; PG8_SCHED;
            PG8_LDB(B0, 1, 0); PG8_LDB(B1, 1, 1); PG8_SCHED; PG8_LDA(At, 1, 0); PG8_STAGE(PG8_SA(0, 1), a2 + hstep, voffA);
            PG8_WAIT_V(8); PG8_WAIT_L(0); PG8_BAR; PG8_MMA(0, 0, At, B0); PG8_MMA(0, 1, At, B1); PG8_BAR; PG8_SCHED;
            PG8_LDA(At, 1, 1); PG8_STAGE(PG8_SB(1, 0), b3, voffB); PG8_STAGE(PG8_SB(1, 1), b3 + hstep, voffB); PG8_STAGE(PG8_SA(1, 0), a3, voffA);
            PG8_WAIT_V(8); PG8_WAIT_L(0); PG8_BAR; PG8_MMA(1, 0, At, B0); PG8_MMA(1, 1, At, B1); PG8_BAR; PG8_SCHED;
            } else {
            PG8_LDB(B0, 0, 0); PG8_SCHED; PG8_LDA(At, 0, 0); PG8_STAGE(PG8_SA(1, 1), a1 + hstep, voffA);
            PG8_WAIT_L(8); PG8_BAR; PG8_WAIT_L(0); PG8_MMA(0, 0, At, B0); PG8_BAR; PG8_SCHED;
            PG8_LDB(B1, 0, 1); PG8_STAGE(PG8_SB(0, 0), b2, voffB);
            PG8_BAR; PG8_WAIT_L(0); PG8_MMA(0, 1, At, B1); PG8_BAR;
            PG8_LDA(At, 0, 1); PG8_STAGE(PG8_SA(0, 0), a2, voffA);
            PG8_BAR; PG8_WAIT_L(0); PG8_MMA(1, 0, At, B0); PG8_BAR; PG8_SCHED;
            PG8_STAGE(PG8_SB(0, 1), b2 + hstep, voffB);
            PG8_WAIT_V(6); PG8_BAR; PG8_MMA(1, 1, At, B1); PG8_BAR;
            PG8_LDB(B0, 1, 0); PG8_SCHED; PG8_LDA(At, 1, 0); PG8_STAGE(PG8_SA(0, 1), a2 + hstep, voffA);
            PG8_WAIT_L(8); PG8_BAR; PG8_WAIT_L(0); PG8_MMA(0, 0, At, B0); PG8_BAR; PG8_SCHED;
            PG8_LDB(B1, 1, 1); PG8_STAGE(PG8_SB(1, 0), b3, voffB);
            PG8_BAR; PG8_WAIT_L(0); PG8_MMA(0, 1, At, B1); PG8_BAR;
            PG8_LDA(At, 1, 1); PG8_STAGE(PG8_SA(1, 0), a3, voffA);
            PG8_BAR; PG8_WAIT_L(0); PG8_MMA(1, 0, At, B0); PG8_BAR; PG8_SCHED;
            PG8_STAGE(PG8_SB(1, 1), b3 + hstep, voffB);
            PG8_WAIT_V(6); PG8_BAR; PG8_MMA(1, 1, At, B1); PG8_BAR;
            }
        }
        if constexpr (ALIGN_EPI) { if (wr == 0) PG8_BAR; }
        if constexpr (!Epi::AFTER_DRAIN) { E(acc, cur, wr, wc, fr, fq); S.done(cur); }
        if (!has_next) break;
#pragma unroll
        for (int a = 0; a < 2; ++a)
#pragma unroll
            for (int b = 0; b < 2; ++b)
#pragma unroll
                for (int m = 0; m < 4; ++m)
#pragma unroll
                    for (int n = 0; n < 2; ++n) acc[a][b][m][n] = (f32x4){0.f, 0.f, 0.f, 0.f};
        cur = nxt; cA = nA; cB = nB; ++ui;
        if constexpr (ALIGN_EPI) { if (wr == 1) PG8_BAR; }
    }
    PG8_WAIT_V(0);
    if constexpr (!ALIGN_EPI) { if (wr == 0) PG8_BAR; }
    PG8_BAR;
    if constexpr (Epi::AFTER_DRAIN) { E.fused(acc, cur, wr, wc, fr, fq, lds, wid, lane); S.done(cur); }
#undef PG8_SA
#undef PG8_SB
#undef PG8_STAGE
#undef PG8_LDA
#undef PG8_LDB
#undef PG8_MMA
#undef PG8_WAIT_V
#undef PG8_WAIT_L
#undef PG8_BAR
#undef PG8_SCHED
}
}
constexpr int NWAVES = 8;
#ifndef MK_N_LAUNCHES
#define MK_N_LAUNCHES 1
#endif
constexpr int N_LAUNCHES = MK_N_LAUNCHES;
constexpr int PER_PHASE = 5;
#ifndef PROBE_REPEAT
#define PROBE_REPEAT -1
#endif

constexpr int BATCH = 32, SEQ = 2048, D = 1024, DA = 512, DB = 512, DIN = 2560;
constexpr int M = BATCH * SEQ;
constexpr float EPS = 1e-6f;

constexpr size_t MiB = 1u << 20;
constexpr size_t WS_CTL = 0, CTL_ZERO_BYTES = 1 * MiB;
constexpr size_t WS_WIN = 2 * MiB;
constexpr size_t WS_WOUT = 8 * MiB;
constexpr size_t WS_WSB = 10 * MiB;
constexpr size_t WS_MT = 11 * MiB;
constexpr size_t WS_ECS = 12 * MiB;
constexpr size_t WS_MTF = 13 * MiB;
constexpr size_t WS_VSTP = 14 * MiB;
constexpr size_t WS_YSQ = 18 * MiB;
constexpr size_t WS_H = 32 * MiB;
constexpr size_t WS_UG = 160 * MiB;
constexpr size_t WS_GV = 224 * MiB;
constexpr size_t WS_Z = 288 * MiB;
constexpr size_t WS_SGB = 352 * MiB;
constexpr size_t WS_X1 = 416 * MiB;
constexpr size_t WS_A2 = 480 * MiB;
constexpr size_t WS_Y = 608 * MiB;
constexpr size_t WS_END = 736 * MiB;
constexpr int CW_TMO = 0, CW_CODE = 1, CW_BAR = 4096;

constexpr int RING_OFF = 0, RING_BYTES = 131072;
constexpr int LDSCTL_OFF = RING_BYTES, MISC_OFF = LDSCTL_OFF + 320;
constexpr int LDS_BYTES = 147456;
static_assert(MISC_OFF + 128 <= LDS_BYTES, "LDS map");


#define GAS __attribute__((address_space(1)))
#define LAS __attribute__((address_space(3)))
typedef unsigned short bf16;
typedef unsigned v4u __attribute__((ext_vector_type(4)));
typedef float f32x4 __attribute__((ext_vector_type(4)));
typedef short bf16x8 __attribute__((ext_vector_type(8)));
typedef GAS unsigned gu32;
typedef GAS unsigned long long gu64;
#define RLX_AGENT __ATOMIC_RELAXED, __HIP_MEMORY_SCOPE_AGENT
#define LDS_WAIT() asm volatile("s_waitcnt lgkmcnt(0)" ::: "memory")
#define VM_WAIT() asm volatile("s_waitcnt vmcnt(0)" ::: "memory")
__device__ __forceinline__ unsigned long long rt() { return __builtin_amdgcn_s_memrealtime(); }
__device__ __forceinline__ unsigned f2bf(float f) { unsigned u = __builtin_bit_cast(unsigned, f); return (u + 0x7fffu + ((u >> 16) & 1u)) >> 16; }
__device__ __forceinline__ unsigned pk2(float lo, float hi) { return f2bf(lo) | (f2bf(hi) << 16); }
#define XB_TMO      128
#define XB_XCNT(j)  (256  + 64 * (j))
#define XB_XSUB(j)  (1280 + 64 * (j))
#define XB_XGEN(j)  (2304 + 64 * (j))
#define XB_TOP      3328
#define XB_TOPGEN   3392
#define XCD_BAR_WORDS 3456
#define XB_SPIN_CAP (1u << 18)

__device__ __forceinline__ unsigned xb_ld(unsigned* p)              { return __hip_atomic_load(p, __ATOMIC_RELAXED, __HIP_MEMORY_SCOPE_AGENT); }
__device__ __forceinline__ unsigned xb_add(unsigned* p, unsigned v) { return __hip_atomic_fetch_add(p, v, __ATOMIC_RELAXED, __HIP_MEMORY_SCOPE_AGENT); }
__device__ __forceinline__ unsigned xb_xcc_id() { return (unsigned)__builtin_amdgcn_s_getreg((3 << 11) | 20) & 0xFu; }
#define XB_SPIN(cond, bar) do { unsigned _sp = 0; while (cond) { __builtin_amdgcn_s_sleep(1); \
    if ((++_sp & 255u) == 0u) { if (xb_ld(&(bar)[XB_TMO])) break; if (_sp > XB_SPIN_CAP) { atomicAdd(&(bar)[XB_TMO], 1u); break; } } } } while (0)

struct XcdBarrier {
    unsigned* bar; unsigned x;
    volatile LAS unsigned* st;
};

__device__ __forceinline__ XcdBarrier xcd_barrier_post(unsigned* bar, volatile LAS unsigned* st) {
    XcdBarrier b; b.bar = bar; b.x = xb_xcc_id(); b.st = st;
    if (threadIdx.x == 0) (void)xb_add(&bar[XB_XCNT(b.x)], 1u);
    return b;
}
__device__ __forceinline__ void xcd_barrier_complete(unsigned* bar, unsigned x, unsigned& nloc, unsigned& nx) {
    const unsigned G = gridDim.x * gridDim.y * gridDim.z;
    unsigned sum, cnt, mine, sp = 0u;
    for (;;) {
        sum = 0u; cnt = 0u; mine = 0u;
#pragma unroll
        for (unsigned j = 0; j < 16; ++j) { const unsigned c = xb_ld(&bar[XB_XCNT(j)]); sum += c; cnt += (c > 0u) ? 1u : 0u; mine = (j == x) ? c : mine; }
        if (sum == G) break;
        __builtin_amdgcn_s_sleep(1);
        if ((++sp & 255u) == 0u) { if (xb_ld(&bar[XB_TMO])) break; if (sp > XB_SPIN_CAP) { atomicAdd(&bar[XB_TMO], 1u); break; } }
    }
    nloc = mine > 0u ? mine : 1u; nx = cnt > 0u ? cnt : 1u;
}

__device__ __forceinline__ void xcd_barrier(const XcdBarrier& b) {
    asm volatile("s_waitcnt vmcnt(0)" ::: "memory");
    __syncthreads();
    if (threadIdx.x == 0) {
        unsigned* bar = b.bar;
        __builtin_amdgcn_s_waitcnt(0);
        unsigned nloc = b.st[0], nx = b.st[1];
        if (nloc == 0u) { xcd_barrier_complete(bar, b.x, nloc, nx); b.st[0] = nloc; b.st[1] = nx; }
        const unsigned old = xb_add(&bar[XB_XSUB(b.x)], 1u);
        const unsigned gen = old / nloc;
        if (old + 1u == (gen + 1u) * nloc) {
            __builtin_amdgcn_fence(__ATOMIC_RELEASE, "agent");
            asm volatile("s_waitcnt vmcnt(0)" ::: "memory");
            const unsigned og = xb_add(&bar[XB_TOP], 1u);
            const unsigned tg = og / nx;
            if (og + 1u == (tg + 1u) * nx) xb_add(&bar[XB_TOPGEN], 1u);
            else XB_SPIN(xb_ld(&bar[XB_TOPGEN]) == tg, bar);
            __builtin_amdgcn_fence(__ATOMIC_ACQUIRE, "agent");
            xb_add(&bar[XB_XGEN(b.x)], 1u);
            asm volatile("s_waitcnt vmcnt(0)" ::: "memory");
        } else {
            XB_SPIN(xb_ld(&bar[XB_XGEN(b.x)]) == gen, bar);
            __builtin_amdgcn_fence(__ATOMIC_ACQUIRE, "agent");
            asm volatile("s_waitcnt vmcnt(0)" ::: "memory");
        }
    }
    __syncthreads();
}
typedef float f32x2 __attribute__((ext_vector_type(2)));
typedef float f32x16 __attribute__((ext_vector_type(16)));
typedef unsigned u32x2 __attribute__((ext_vector_type(2)));
using pg8::pk_bf16;
struct Frame {
    LAS unsigned char* lds;
    volatile LAS unsigned* MISC;
    gu32* ctl;
    int tid, lane, wave;
    int vcu, G;
    const float *x, *pre_g, *post_g, *w_in, *ln_g, *ln_b, *w_s, *b_s, *w_f, *b_f, *w_out; float* out;
    bf16 *WIN, *WOUT, *WSB, *MT, *MTF, *ECS, *H, *UG, *GV, *Z, *SGB, *X1, *A2, *Y;
    float *VSTP, *YSQ;
};
__device__ __forceinline__ float bflo(unsigned w) { return __builtin_bit_cast(float, w << 16); }
__device__ __forceinline__ float bfhi(unsigned w) { return __builtin_bit_cast(float, w & 0xffff0000u); }
__device__ __forceinline__ float wave_sum(float v) {
#pragma unroll
    for (int o = 1; o < 64; o <<= 1) v += __shfl_xor(v, o);
    return v;
}
__device__ __forceinline__ int win_src_col(int n) { const int t = n >> 8, r = n & 255; return t < 4 ? (r < 128 ? t * 128 + r : 1024 + t * 128 + (r - 128)) : (t < 6 ? 512 + (t - 4) * 256 + r : (t < 8 ? 1536 + (t - 6) * 256 + r : 2048 + (t - 8) * 256 + r)); }
__device__ __forceinline__ void p0_transpose_item(const float* W, int K, int N, bf16* WT, const float* kscale, bool remap, LAS float* scr, int item, int lane) {
    const int nblk = N / 32, kb = item / nblk, nb = item % nblk, k0 = 64 * kb, n0 = 32 * nb, s0 = remap ? win_src_col(n0) : n0;
#pragma unroll 8
    for (int i = 0; i < 32; ++i) { const int kk = 2 * i + (lane >> 5); float v = W[(size_t)(k0 + kk) * N + s0 + (lane & 31)]; if (kscale) v *= kscale[k0 + kk]; scr[kk * 33 + (lane & 31)] = v; }
    LDS_WAIT(); asm volatile("" ::: "memory");
    const int c = lane & 7;
#pragma unroll
    for (int j = 0; j < 4; ++j) { const int n = (lane >> 3) + 8 * j; const LAS float* s = scr + (8 * c) * 33 + n;
        v4u o; o.x = pk_bf16(s[0 * 33], s[1 * 33]); o.y = pk_bf16(s[2 * 33], s[3 * 33]); o.z = pk_bf16(s[4 * 33], s[5 * 33]); o.w = pk_bf16(s[6 * 33], s[7 * 33]);
        *(GAS v4u*)(WT + (size_t)(n0 + n) * K + k0 + 8 * c) = o; }
    LDS_WAIT(); asm volatile("" ::: "memory");
}
__device__ __forceinline__ void rms_rows4_to_bf16(Frame& F, const float* xrow, bf16* orow) {
    f32x4 v[4][4]; float s[4];
#pragma unroll
    for (int i = 0; i < 4; ++i) { const GAS f32x4* xr = (const GAS f32x4*)(xrow + (size_t)i * D) + F.lane;
#pragma unroll
        for (int j = 0; j < 4; ++j) v[i][j] = xr[64 * j]; }
#pragma unroll
    for (int i = 0; i < 4; ++i) { s[i] = 0.f;
#pragma unroll
        for (int j = 0; j < 4; ++j) s[i] += (v[i][j].x * v[i][j].x + v[i][j].y * v[i][j].y) + (v[i][j].z * v[i][j].z + v[i][j].w * v[i][j].w); }
#pragma unroll
    for (int o = 1; o < 64; o <<= 1) {
#pragma unroll
        for (int i = 0; i < 4; ++i) s[i] += __shfl_xor(s[i], o); }
#pragma unroll
    for (int i = 0; i < 4; ++i) { const float r = rsqrtf(s[i] * (1.f / D) + EPS); GAS u32x2* o8 = (GAS u32x2*)(orow + (size_t)i * D) + F.lane;
#pragma unroll
        for (int j = 0; j < 4; ++j) o8[64 * j] = (u32x2){pk_bf16(v[i][j].x * r, v[i][j].y * r), pk_bf16(v[i][j].z * r, v[i][j].w * r)}; }
}
__device__ __forceinline__ void p0_prologue(Frame& F) {
    LAS float* scr = (LAS float*)(F.lds + RING_OFF + F.wave * 16384);
    const int gw = F.vcu * NWAVES + F.wave, NGW = F.G * NWAVES;
    constexpr int I_IN = (D / 64) * (DIN / 32), I_OUT = (D / 64) * (D / 32);
    for (int it = gw; it < I_IN + I_OUT; it += NGW) {
        if (it < I_IN) p0_transpose_item(F.w_in, D, DIN, F.WIN, F.pre_g, true, scr, it, F.lane);
        else p0_transpose_item(F.w_out, D, D, F.WOUT, nullptr, false, scr, it - I_IN, F.lane);
    }
    const int gt = gw * 64 + F.lane, NT = NGW * 64;
    for (int i = gt; i < 4 * 128 * 128 / 2; i += NT) { const f32x2 v = *(const f32x2*)(F.w_s + 2 * i); ((unsigned*)F.WSB)[i] = pk_bf16(v.x, v.y); }
    for (int i = gt; i < 16 * 4 * 16 * 64; i += NT) {
        const int ln = i & 63, scs = (i >> 6) & 15, kt = (i >> 10) & 3, k1 = i >> 12, k2 = 32 * kt + (ln & 31), h = ln >> 5, st = scs >> 2, c = (scs >> 1) & 1, s = scs & 1;
        float v[8];
#pragma unroll
        for (int j = 0; j < 8; ++j) { const int sl = 32 * st + 16 * s + 8 * (j >> 2) + 4 * h + (j & 3); const int idx = ((k1 + 16 * k2) * sl) & 2047; float sn, cs; sincospif((float)idx * (1.0f / 1024.0f), &sn, &cs); v[j] = c ? sn : cs; }
        v4u o; o.x = pk_bf16(v[0], v[1]); o.y = pk_bf16(v[2], v[3]); o.z = pk_bf16(v[4], v[5]); o.w = pk_bf16(v[6], v[7]);
        *(v4u*)(F.ECS + (size_t)i * 8) = o;
    }
    {   LAS float* ctab = (LAS float*)(F.lds + RING_OFF + F.wave * 16384 + 12288);
        { float sn, cs; sincospif((float)F.lane * (1.0f / 64.0f), &sn, &cs); ctab[F.lane] = cs; ctab[64 + F.lane] = -cs; }
        LDS_WAIT(); asm volatile("" ::: "memory");
        for (int i = gt; i < 4 * 128 * 128; i += NT) {
            const int c = i & 127, e = (i >> 7) & 127, g = i >> 14; float wc = 0.f, ws = 0.f; const float* wf = F.w_f + (size_t)g * 16384 + e;
#pragma unroll 8
            for (int m = 0; m < 128; ++m) { const int ph = (c * m) & 127; const float w = wf[(size_t)m * 128]; wc += ctab[ph] * w; ws += ctab[(ph + 96) & 127] * w; }
            wc *= (1.0f / 512.0f); ws *= (1.0f / 512.0f);
            unsigned short* mt = (unsigned short*)F.MT + (size_t)g * 65536;
            const unsigned pc = pk_bf16(wc, -ws);
            mt[(size_t)e * 256 + c] = (unsigned short)pc; mt[(size_t)e * 256 + 128 + c] = (unsigned short)(pk_bf16(ws, 0.f));
            mt[(size_t)(128 + e) * 256 + c] = (unsigned short)(pc >> 16); mt[(size_t)(128 + e) * 256 + 128 + c] = (unsigned short)pc;
        }
        LDS_WAIT(); asm volatile("" ::: "memory");
    }
    for (int m = 4 * gw; m < M; m += 4 * NGW) rms_rows4_to_bf16(F, F.x + (size_t)m * D, F.H + (size_t)m * D);
}

__device__ __forceinline__ int lnt_key(int c) { return ((c ^ (c >> 5)) & 1) | (((c >> 3) & 3) << 1) | (((c >> 1) & 1) << 3); }
__device__ __forceinline__ int lnt_off(int c, int qchunk) { return c * 256 + ((qchunk ^ lnt_key(c)) << 4); }
__device__ __forceinline__ void p2_spatial_all(Frame& F) {
    const int tid = F.tid, lane = F.lane, w = F.wave;
    LAS float* st_mu = (LAS float*)(F.lds + 65536);
    LAS float* st_rs = st_mu + 256;
    const int nch = ((int)blockIdx.x + F.G < 512) ? 2 : (((int)blockIdx.x < 512) ? 1 : 0);
    if (nch == 0) return;
    if (tid < 128 * nch) {
        const int cc = tid >> 7, q = tid & 127; const float* sp = F.VSTP + (size_t)(((int)blockIdx.x + cc * F.G) * 128 + q) * 16; float sm = 0.f, qq = 0.f;
#pragma unroll
        for (int i = 0; i < 8; ++i) { sm += sp[2 * i]; qq += sp[2 * i + 1]; }
        const float mu = sm * (1.f / DA), var = fmaxf(qq * (1.f / DA) - mu * mu, 0.f);
        st_mu[tid] = mu; st_rs[tid] = rsqrtf(var + EPS);
    }
    const int cg = lane & 15, tq = lane >> 4, q0 = 16 * w + 4 * tq;
    const int fr = lane & 15, fq = lane >> 4, wcb = (w & 3) * 32, ph = (w >> 2) * 64;
    const int nit = 4 * nch;
    v4u raw[4], ug[4]; bf16x8 wsf[4][4];
#define SP_M0(n) ((((int)blockIdx.x) + ((n) % nch) * F.G) * 128)
#define SP_LDRAW(n) do { const int h_ = (n) / nch, m0_ = SP_M0(n); _Pragma("unroll") for (int i = 0; i < 4; ++i) raw[i] = *(const v4u*)(F.GV + (size_t)(m0_ + q0 + i) * 512 + h_ * 128 + 8 * cg); } while (0)
    SP_LDRAW(0);
    __syncthreads();
#pragma unroll 1
    for (int n = 0; n < nit; ++n) {
        const int h = n / nch, cc = n % nch, m0 = SP_M0(n);
        LAS unsigned char* lnt = F.lds + (n & 1) * 32768;
        {
            float mu4[4], rs4[4];
#pragma unroll
            for (int i = 0; i < 4; ++i) { mu4[i] = st_mu[cc * 128 + q0 + i]; rs4[i] = st_rs[cc * 128 + q0 + i]; }
            const f32x4 g0 = *(const f32x4*)(F.ln_g + h * 128 + 8 * cg), g1 = *(const f32x4*)(F.ln_g + h * 128 + 8 * cg + 4);
            const f32x4 b0 = *(const f32x4*)(F.ln_b + h * 128 + 8 * cg), b1 = *(const f32x4*)(F.ln_b + h * 128 + 8 * cg + 4);
#pragma unroll
            for (int j = 0; j < 8; ++j) {
                const float gg = j < 4 ? g0[j & 3] : g1[j & 3], bb = j < 4 ? b0[j & 3] : b1[j & 3];
                float v[4];
#pragma unroll
                for (int i = 0; i < 4; ++i) { const unsigned wd = raw[i][j >> 1]; const float xv = (j & 1) ? bfhi(wd) : bflo(wd); v[i] = (xv - mu4[i]) * rs4[i] * gg + bb; }
                const int c = 8 * cg + j;
                *(LAS u32x2*)(lnt + lnt_off(c, q0 >> 3) + (q0 & 7) * 2) = (u32x2){pk_bf16(v[0], v[1]), pk_bf16(v[2], v[3])};
            }
        }
        if (n + 1 < nit) SP_LDRAW(n + 1);
#pragma unroll
        for (int t = 0; t < 4; ++t) ug[t] = *(const v4u*)(F.UG + (size_t)(m0 + ph + 16 * t + fr) * 512 + h * 128 + wcb + 8 * fq);
        if (cc == 0) {
#pragma unroll
            for (int t = 0; t < 4; ++t)
#pragma unroll
                for (int ks = 0; ks < 4; ++ks) wsf[t][ks] = *(const bf16x8*)(F.WSB + (size_t)(h * 128 + ph + 16 * t + fr) * 128 + 32 * ks + 8 * fq);
        }
        __syncthreads();
        f32x4 acc[2][4];
#pragma unroll
        for (int nn = 0; nn < 2; ++nn)
#pragma unroll
            for (int t = 0; t < 4; ++t) acc[nn][t] = (f32x4){0.f, 0.f, 0.f, 0.f};
#pragma unroll
        for (int ks = 0; ks < 4; ++ks) {
            bf16x8 a[2];
#pragma unroll
            for (int nn = 0; nn < 2; ++nn) { const int c = wcb + 8 * (fr >> 2) + 4 * nn + (fr & 3); a[nn] = *(const LAS bf16x8*)(lnt + lnt_off(c, 4 * ks + fq)); }
#pragma unroll
            for (int t = 0; t < 4; ++t)
#pragma unroll
                for (int nn = 0; nn < 2; ++nn) acc[nn][t] = __builtin_amdgcn_mfma_f32_16x16x32_bf16(a[nn], wsf[t][ks], acc[nn][t], 0, 0, 0);
        }
#pragma unroll
        for (int t = 0; t < 4; ++t) {
            const int p = ph + 16 * t + fr; const float bs = F.b_s[h * 128 + p]; const v4u u4 = ug[t];
            v4u o;
            o.x = pk_bf16((acc[0][t][0] + bs) * bflo(u4.x), (acc[0][t][1] + bs) * bfhi(u4.x)); o.y = pk_bf16((acc[0][t][2] + bs) * bflo(u4.y), (acc[0][t][3] + bs) * bfhi(u4.y));
            o.z = pk_bf16((acc[1][t][0] + bs) * bflo(u4.z), (acc[1][t][1] + bs) * bfhi(u4.z)); o.w = pk_bf16((acc[1][t][2] + bs) * bflo(u4.w), (acc[1][t][3] + bs) * bfhi(u4.w));
            *(v4u*)(F.A2 + (size_t)(m0 + p) * 1024 + h * 128 + wcb + 8 * fq) = o;
        }
    }
#undef SP_M0
#undef SP_LDRAW
    __syncthreads();
}
__device__ __forceinline__ void dft16(const float (&z)[16], float (&r)[16]) {
    constexpr float C16[16] = {1.f, 0.92387953251f, 0.70710678119f, 0.38268343237f, 0.f, -0.38268343237f, -0.70710678119f, -0.92387953251f, -1.f, -0.92387953251f, -0.70710678119f, -0.38268343237f, 0.f, 0.38268343237f, 0.70710678119f, 0.92387953251f};
    float e[8], o[8];
#pragma unroll
    for (int s = 1; s < 8; ++s) { e[s] = z[s] + z[16 - s]; o[s] = z[s] - z[16 - s]; }
#pragma unroll
    for (int k = 0; k <= 8; ++k) { float a = (k & 1) ? z[0] - z[8] : z[0] + z[8];
#pragma unroll
        for (int s = 1; s < 8; ++s) a += C16[(k * s) & 15] * e[s];
        r[k] = a; }
#pragma unroll
    for (int k = 1; k < 8; ++k) { float a = 0.f;
#pragma unroll
        for (int s = 1; s < 8; ++s) a -= C16[(k * s + 12) & 15] * o[s];
        r[8 + k] = a; }
}
__device__ __forceinline__ size_t dft_item_off(const Frame& F, int n, bool out) {
    const int it = ((int)blockIdx.x + (n >> 1) * F.G) * 512 + F.tid, b = it >> 13, s_lo = (it >> 6) & 127;
    return ((size_t)(out ? b * 16 * 128 : b * 2048) + s_lo) * 512 + 8 * (F.tid & 63) + 4 * (n & 1);
}
__device__ __forceinline__ void dft_load(const Frame& F, int n, u32x2 (&dst)[16]) { const bf16* zp = F.Z + dft_item_off(F, n, false);
#pragma unroll
    for (int s = 0; s < 16; ++s) dst[s] = *(const u32x2*)(zp + (size_t)s * 128 * 512); }
__device__ __forceinline__ void dft_do(const Frame& F, int n, const u32x2 (&src)[16]) {
    u32x2 outp[16];
#pragma unroll
    for (int jp = 0; jp < 2; ++jp) { float zl[16], zh[16], rl[16], rh[16];
#pragma unroll
        for (int s = 0; s < 16; ++s) { zl[s] = bflo(src[s][jp]); zh[s] = bfhi(src[s][jp]); }
        dft16(zl, rl); dft16(zh, rh);
#pragma unroll
        for (int pl = 0; pl < 16; ++pl) outp[pl][jp] = pk_bf16(rl[pl], rh[pl]); }
    bf16* xp = F.X1 + dft_item_off(F, n, true);
#pragma unroll
    for (int pl = 0; pl < 16; ++pl) *(u32x2*)(xp + (size_t)pl * 128 * 512) = outp[pl];
}
__device__ __forceinline__ void p2_dft16_all(Frame& F) {
    const int nun = ((int)blockIdx.x + F.G < 512) ? 2 : (((int)blockIdx.x < 512) ? 1 : 0), nit = 2 * nun;
    if (nit == 0) return;
    u32x2 inA[16], inB[16];
    dft_load(F, 0, inA);
#pragma unroll 1
    for (int n = 0; n < nit; n += 2) {
        dft_load(F, n + 1, inB);
        dft_do(F, n, inA);
        if (n + 2 < nit) dft_load(F, n + 2, inA);
        dft_do(F, n + 1, inB);
    }
}
__device__ __forceinline__ v4u pack8(const f32x16& x, int s) { v4u p; p.x = pk_bf16(x[8 * s], x[8 * s + 1]); p.y = pk_bf16(x[8 * s + 2], x[8 * s + 3]); p.z = pk_bf16(x[8 * s + 4], x[8 * s + 5]); p.w = pk_bf16(x[8 * s + 6], x[8 * s + 7]); return p; }
__device__ __forceinline__ void p3_unit_decode(int ui, int& b, int& k1) { b = ui >> 4; const int j = ui & 15; k1 = j < 8 ? j : (j == 8 ? 8 : 24 - j); }
__device__ __forceinline__ void p2_mtf(Frame& F) {
    const int gt = (F.vcu * NWAVES + F.wave) * 64 + F.lane, NT = F.G * NWAVES * 64;
    for (int i2 = gt; i2 < 2 * 32768; i2 += NT) { const int i = i2 & 32767, ln = i & 63, ks = (i >> 6) & 15, et = (i >> 10) & 3, c = (i >> 12) & 1, g = i >> 13;
        v4u t = *(const v4u*)(F.MT + ((size_t)(g * 256 + c * 128 + et * 32 + (ln & 31))) * 256 + 16 * ks + 8 * (ln >> 5));
        const unsigned fl = (i2 >= 32768 && ks >= 8) ? 0x80008000u : 0u; t.x ^= fl; t.y ^= fl; t.z ^= fl; t.w ^= fl;
        *(v4u*)(F.MTF + (size_t)i2 * 8) = t; }
}
__device__ __forceinline__ void p3_slab_dma(Frame& F, LAS unsigned char* slab, int b, int k1, int g) {
    const int k1p = k1 <= 8 ? k1 : 16 - k1; const bool has_im = (k1p != 0 && k1p != 8);
    const bf16* xr = F.X1 + ((size_t)(b * 16 + k1p) * 128) * 512 + g * 128; const bf16* xi = has_im ? F.X1 + ((size_t)(b * 16 + 8 + k1p) * 128) * 512 + g * 128 : xr;
    int ln = F.lane; asm volatile("" : "+v"(ln));
#pragma unroll
    for (int i = 0; i < 8; ++i) { const int pc = i * 8 + F.wave, row = 2 * pc + (ln >> 5), c = (ln & 31) ^ (row & 15);
        const bf16* src = (c >= 16 ? xi : xr) + (size_t)row * 512 + (c & 15) * 8;
        __builtin_amdgcn_global_load_lds((const unsigned*)src, (LAS unsigned*)(slab + pc * 1024), 16, 0, 0); }
}
__device__ __forceinline__ void p3_fourier_all(Frame& F) {
    LAS unsigned char* slab = F.lds; LAS unsigned char* xb = F.lds + 65536;
    const int lane = F.lane, w = F.wave, r = lane & 31, hh = lane >> 5;
    const int et1 = w & 3, c1 = w >> 2;
    const int kt2 = w & 3, eh2 = w >> 2;
    bf16x8 bm[16];
#define P3_LDBM16(gg, cj) do { _Pragma("unroll") for (int q_ = 0; q_ < 16; ++q_) bm[q_] = *(const bf16x8*)(F.MTF + (size_t)(cj) * 262144 + ((((size_t)(gg) * 2 + c1) * 4 + et1) * 16 + q_) * 512 + lane * 8); } while (0)
    bool first = true;
#pragma unroll 1
    for (int ui = blockIdx.x; ui < 512; ui += F.G) {
        int b, k1; p3_unit_decode(ui, b, k1);
        const int k1p = k1 <= 8 ? k1 : 16 - k1; const bool has_im = (k1p != 0 && k1p != 8);
        bf16x8 Ef[16];
#pragma unroll
        for (int scs = 0; scs < 16; ++scs) Ef[scs] = *(const bf16x8*)(F.ECS + ((((size_t)k1 * 4 + kt2) * 16 + scs) * 64 + lane) * 8);
        if (first) { p3_slab_dma(F, slab, b, k1, 0); P3_LDBM16(0, k1 > 8 ? 1 : 0); asm volatile("s_waitcnt vmcnt(0)" ::: "memory"); __syncthreads(); first = false; }
        const int k2 = 32 * kt2 + r;
#pragma unroll 1
        for (int g = 0; g < 4; ++g) {
#pragma unroll
            for (int pass = 0; pass < 2; ++pass) {
                f32x16 Dt[2];
#pragma unroll
                for (int a = 0; a < 2; ++a)
#pragma unroll
                    for (int i = 0; i < 16; ++i) Dt[a][i] = 0.f;
#pragma unroll
                for (int ks = 0; ks < 16; ++ks) {
                    if (ks < 8 || has_im) {
#pragma unroll
                        for (int sti = 0; sti < 2; ++sti) { const int row = 32 * (2 * pass + sti) + r; const bf16x8 ax = *(const LAS bf16x8*)(slab + row * 512 + (((2 * ks + hh) ^ (row & 15)) << 4));
                            Dt[sti] = __builtin_amdgcn_mfma_f32_32x32x16_bf16(ax, bm[ks], Dt[sti], 0, 0, 0); }
                    }
                }
#pragma unroll
                for (int sti = 0; sti < 2; ++sti)
#pragma unroll
                    for (int s = 0; s < 2; ++s) *(LAS v4u*)(xb + (((((2 * pass + sti) * 2 + c1) * 2 + s) * 4 + et1) << 10) + lane * 16) = pack8(Dt[sti], s);
            }
            __syncthreads();
            const bool nxt_unit = (g == 3), has_next = !nxt_unit || (ui + F.G < 512);
            if (has_next) { int nb = b, nk1 = k1; if (nxt_unit) p3_unit_decode(ui + F.G, nb, nk1); p3_slab_dma(F, slab, nb, nk1, nxt_unit ? 0 : g + 1); }
            f32x16 Yt[2];
#pragma unroll
            for (int a = 0; a < 2; ++a)
#pragma unroll
                for (int i = 0; i < 16; ++i) Yt[a][i] = 0.f;
#pragma unroll
            for (int scs = 0; scs < 16; ++scs)
#pragma unroll
                for (int eti = 0; eti < 2; ++eti) { const bf16x8 df = *(const LAS bf16x8*)(xb + ((scs * 4 + 2 * eh2 + eti) << 10) + lane * 16);
                    Yt[eti] = __builtin_amdgcn_mfma_f32_32x32x16_bf16(df, Ef[scs], Yt[eti], 0, 0, 0); }
            int tidl = F.tid; asm volatile("" : "+v"(tidl));
            v4u sgq[4];
#pragma unroll
            for (int i = 0; i < 4; ++i) { const int cidx = i * 512 + tidl, rw = cidx >> 4, ch = cidx & 15; sgq[i] = *(const v4u*)(F.SGB + ((size_t)b * 2048 + k1 + 16 * rw) * 512 + g * 128 + ch * 8); }
            __syncthreads();
#pragma unroll
            for (int eti = 0; eti < 2; ++eti)
#pragma unroll
                for (int qd = 0; qd < 4; ++qd) { const int el = (2 * eh2 + eti) * 32 + 8 * qd + 4 * hh; const f32x4 bias = *(const f32x4*)(F.b_f + g * 128 + el);
                    const u32x2 o = {pk_bf16(Yt[eti][4 * qd + 0] + bias[0], Yt[eti][4 * qd + 1] + bias[1]), pk_bf16(Yt[eti][4 * qd + 2] + bias[2], Yt[eti][4 * qd + 3] + bias[3])};
                    *(LAS u32x2*)(xb + k2 * 256 + ((((el >> 3) ^ (k2 & 15)) << 4) | (hh << 3))) = o; }
            if (has_next) { int nb = b, nk1 = k1; if (nxt_unit) p3_unit_decode(ui + F.G, nb, nk1); P3_LDBM16(nxt_unit ? 0 : g + 1, nk1 > 8 ? 1 : 0); }
            __syncthreads();
#pragma unroll
            for (int i = 0; i < 4; ++i) { const int cidx = i * 512 + tidl, rw = cidx >> 4, ch = cidx & 15;
                const v4u yv = *(const LAS v4u*)(xb + rw * 256 + ((ch ^ (rw & 15)) << 4)); const v4u sv = sgq[i];
                v4u o; o.x = pk_bf16(bflo(yv.x) * bflo(sv.x), bfhi(yv.x) * bfhi(sv.x)); o.y = pk_bf16(bflo(yv.y) * bflo(sv.y), bfhi(yv.y) * bfhi(sv.y));
                o.z = pk_bf16(bflo(yv.z) * bflo(sv.z), bfhi(yv.z) * bfhi(sv.z)); o.w = pk_bf16(bflo(yv.w) * bflo(sv.w), bfhi(yv.w) * bfhi(sv.w));
                *(v4u*)(F.A2 + ((size_t)b * 2048 + k1 + 16 * rw) * 1024 + 512 + g * 128 + ch * 8) = o; }
            asm volatile("s_waitcnt vmcnt(0)" ::: "memory");
            __syncthreads();
        }
    }
#undef P3_LDBM16
}
__device__ __forceinline__ void p5_final_rows(Frame& F, int row0, int nrows) {
    const int lane = F.lane;
    f32x4 pg[4];
#pragma unroll
    for (int j = 0; j < 4; ++j) pg[j] = *(const f32x4*)(F.post_g + 4 * lane + 256 * j);
    for (int mb = row0 + 4 * F.wave; mb < row0 + nrows; mb += 4 * NWAVES) {
        float qv = F.YSQ[(size_t)mb * 16 + lane];
        u32x2 y[4][4]; f32x4 xv[4][4];
#pragma unroll
        for (int i = 0; i < 4; ++i) {
#pragma unroll
            for (int j = 0; j < 4; ++j) { y[i][j] = *(const u32x2*)(F.Y + (size_t)(mb + i) * D + 4 * lane + 256 * j); xv[i][j] = *(const f32x4*)(F.x + (size_t)(mb + i) * D + 4 * lane + 256 * j); } }
        qv += __shfl_xor(qv, 1); qv += __shfl_xor(qv, 2); qv += __shfl_xor(qv, 4); qv += __shfl_xor(qv, 8);
#pragma unroll
        for (int i = 0; i < 4; ++i) {
            const float rstd = rsqrtf(__shfl(qv, 16 * i) * (1.f / D) + EPS);
#pragma unroll
            for (int j = 0; j < 4; ++j) { const unsigned w0 = y[i][j].x, w1 = y[i][j].y;
                f32x4 o; o.x = xv[i][j].x + bflo(w0) * rstd * pg[j].x; o.y = xv[i][j].y + bfhi(w0) * rstd * pg[j].y; o.z = xv[i][j].z + bflo(w1) * rstd * pg[j].z; o.w = xv[i][j].w + bfhi(w1) * rstd * pg[j].w;
                *(f32x4*)(F.out + (size_t)(mb + i) * D + 4 * lane + 256 * j) = o; }
        }
    }
}

struct Args { const float* in[11]; float* out; unsigned char* ws; int ph_lo, ph_hi, li, pad; };
__global__ void __launch_bounds__(NWAVES * 64, 2) mega_fwd(Args args) {
    extern __shared__ __attribute__((aligned(16))) unsigned char lds[];
    Frame F;
    F.lds = (LAS unsigned char*)lds;
    F.MISC = (volatile LAS unsigned*)(F.lds + MISC_OFF);
    F.tid = threadIdx.x; F.lane = F.tid & 63; F.wave = __builtin_amdgcn_readfirstlane(F.tid >> 6);
    F.G = gridDim.x; { const int bx = blockIdx.x; F.vcu = (F.G % 8 == 0) ? (bx % 8) * (F.G / 8) + bx / 8 : bx; }
    unsigned char* ws = args.ws;
    F.ctl = (gu32*)(ws + WS_CTL);
    F.x = args.in[0]; F.pre_g = args.in[1]; F.post_g = args.in[2]; F.w_in = args.in[3]; F.ln_g = args.in[4]; F.ln_b = args.in[5]; F.w_s = args.in[6]; F.b_s = args.in[7];
    F.w_f = args.in[8]; F.b_f = args.in[9]; F.w_out = args.in[10]; F.out = args.out;
    F.WIN = (bf16*)(ws + WS_WIN); F.WOUT = (bf16*)(ws + WS_WOUT); F.WSB = (bf16*)(ws + WS_WSB); F.MT = (bf16*)(ws + WS_MT); F.MTF = (bf16*)(ws + WS_MTF); F.ECS = (bf16*)(ws + WS_ECS);
    F.H = (bf16*)(ws + WS_H); F.UG = (bf16*)(ws + WS_UG); F.GV = (bf16*)(ws + WS_GV); F.Z = (bf16*)(ws + WS_Z); F.SGB = (bf16*)(ws + WS_SGB); F.X1 = (bf16*)(ws + WS_X1);
    F.A2 = (bf16*)(ws + WS_A2); F.Y = (bf16*)(ws + WS_Y); F.VSTP = (float*)(ws + WS_VSTP); F.YSQ = (float*)(ws + WS_YSQ);
    for (int u = F.tid; u < (LDS_BYTES - LDSCTL_OFF) / 4; u += NWAVES * 64) ((LAS unsigned*)(F.lds + LDSCTL_OFF))[u] = 0u;
    __syncthreads();
    XcdBarrier bar; bar.bar = (unsigned*)(F.ctl + CW_BAR); bar.x = 0; bar.st = nullptr;
    if (N_LAUNCHES != PER_PHASE) bar = xcd_barrier_post((unsigned*)(F.ctl + CW_BAR), F.MISC + 8);
#define GRID_BAR() do { if (N_LAUNCHES != PER_PHASE) xcd_barrier(bar); } while (0)
    const int lo = args.ph_lo, hi = args.ph_hi;
#define IN(k) (lo <= (k) && (k) < hi)
#define BOTH(k) (IN(k) && IN((k) + 1))
    if (IN(0)) { p0_prologue(F); if (BOTH(0)) GRID_BAR(); }
    if (IN(1)) {
        pg8::Gemm g{F.H, F.WIN, M, DIN, D}; pg8::StaticOrder S; S.init(M, DIN, F.G, (int)blockIdx.x);
        pg8::EpiIn E{F.UG, F.GV, F.Z, F.SGB, F.VSTP};
        pg8::gemm_phase<pg8::EpiIn, pg8::StaticOrder, true, true>(F.lds + RING_OFF, g, S, E);
        if (BOTH(1)) GRID_BAR();
    }
    if (IN(2)) {
        p2_mtf(F);
        p2_spatial_all(F);
        p2_dft16_all(F);
        if (BOTH(2)) GRID_BAR();
    }
    if (IN(3)) {
        p3_fourier_all(F);
        if (BOTH(3)) GRID_BAR();
    }
    if (IN(4)) {
        pg8::Gemm g{F.A2, F.WOUT, M, D, D}; pg8::PanelOrder S{F.G, F.vcu, M / 256, D / 256};
        pg8::EpiY E{F.Y, F.YSQ};
        pg8::gemm_phase<pg8::EpiY, pg8::PanelOrder, true, true>(F.lds + RING_OFF, g, S, E);
        __builtin_amdgcn_fence(__ATOMIC_ACQUIRE, "agent");
        for (int pm = F.vcu; pm < M / 256; pm += F.G) p5_final_rows(F, pm * 256, 256);
    }
#undef IN
#undef BOTH
}

extern "C" void kernel_launch(void* const* d_in, const int* in_sizes, int n_in, void* d_out, int out_size, void* d_ws, size_t ws_size, hipStream_t stream) {
    static int grid = 0;
    if (grid == 0) {
        if (n_in != 11 || in_sizes[0] != M * D || out_size != M * D || ws_size < WS_END) { fprintf(stderr, "kernel_launch: unexpected shapes / workspace (n_in %d, in0 %d, out %d, ws %zu)\n", n_in, n_in > 0 ? in_sizes[0] : -1, out_size, ws_size); grid = -1; return; }
        int dev = 0, cus = 0, per_cu = 0;
        if (hipGetDevice(&dev) != hipSuccess || hipDeviceGetAttribute(&cus, hipDeviceAttributeMultiprocessorCount, dev) != hipSuccess) { grid = -1; return; }
        if (hipFuncSetAttribute((const void*)mega_fwd, hipFuncAttributeMaxDynamicSharedMemorySize, LDS_BYTES) != hipSuccess) { fprintf(stderr, "kernel_launch: hipFuncSetAttribute failed\n"); grid = -1; return; }
        if (hipOccupancyMaxActiveBlocksPerMultiprocessor(&per_cu, (const void*)mega_fwd, NWAVES * 64, LDS_BYTES) != hipSuccess || per_cu < 1) { fprintf(stderr, "kernel_launch: occupancy query says %d blocks per CU\n", per_cu); (void)hipGetLastError(); per_cu = 1; }
        grid = cus;
    }
    if (grid < 0) return;
    (void)hipMemsetAsync((char*)d_ws + WS_CTL, 0, CTL_ZERO_BYTES, stream);
    Args a; memset(&a, 0, sizeof(a));
    for (int i = 0; i < 11; ++i) a.in[i] = (const float*)d_in[i];
    a.out = (float*)d_out; a.ws = (unsigned char*)d_ws;
    for (int li = 0; li < N_LAUNCHES; ++li) {
        a.ph_lo = (N_LAUNCHES == PER_PHASE) ? li : 0; a.ph_hi = (N_LAUNCHES == PER_PHASE) ? li + 1 : PER_PHASE; a.li = li;
        hipLaunchKernelGGL(mega_fwd, dim3(grid), dim3(NWAVES * 64), LDS_BYTES, stream, a);
    }
    if (PROBE_REPEAT >= 0) { a.ph_lo = PROBE_REPEAT; a.ph_hi = PROBE_REPEAT + 1; a.li = 1; hipLaunchKernelGGL(mega_fwd, dim3(grid), dim3(NWAVES * 64), LDS_BYTES, stream, a); }
}
```

```cpp
#include <hip/hip_runtime.h>
#include <cstdio>
#include <cstdint>
#include <cstring>

namespace pg8 {
#define PG8_LAS __attribute__((address_space(3)))
typedef unsigned short bf16_t;
typedef short bf16x8 __attribute__((ext_vector_type(8)));
typedef float f32x4 __attribute__((ext_vector_type(4)));
typedef unsigned u32x4 __attribute__((ext_vector_type(4)));
constexpr int BM = 256, BK = 64, HALF = 128, HTB = HALF * BK * 2  , STAGE_BYTES = 8 * HTB, NXCD = 8, WGM = 8;

__host__ __device__ __forceinline__ int lds_byte(int r, int c) { const int st = (r >> 4) * 2 + (c >> 5), rr = r & 15, cc = c & 31, ob = rr * 64 + cc * 2; return st * 1024 + (ob ^ (((ob >> 9) & 1) << 5)); }
__host__ __device__ __forceinline__ void stage_rc(int b, int& R, int& C) { const int st = b / 1024, sb = b % 1024, swz = sb ^ (((sb >> 9) & 1) << 5); R = (st >> 1) * 16 + swz / 64; C = (st & 1) * 32 + (swz % 64) / 2; }
__host__ __device__ __forceinline__ int perm32(int rho) { const int n = rho >> 4, i = rho & 15; return 8 * (i >> 2) + 4 * n + (i & 3); }

struct Unit { int pm, pn; };
struct Gemm { const bf16_t* A; const bf16_t* Bt; int M, N, K; };

struct StaticOrder {
    int nM, nN, nwg, G, c;
    __host__ __device__ void init(int M, int N, int G_, int c_) { nM = M / BM; nN = N / BM; nwg = nM * nN; G = G_; c = c_; }
    __host__ __device__ bool next(int i, Unit& u) const {
        const long L = (long)i * G + c; if (L >= nwg) return false;
        int wgid = (int)L; { const int q = nwg / NXCD, r = nwg % NXCD, xcd = wgid % NXCD, off = wgid / NXCD; wgid = (xcd < r ? xcd * (q + 1) : r * (q + 1) + (xcd - r) * q) + off; }
        const int nig = WGM * nN, gid = wgid / nig, fm = gid * WGM, gsz = (nM - fm) < WGM ? (nM - fm) : WGM;
        u.pm = fm + ((wgid % nig) % gsz); u.pn = (wgid % nig) / gsz; return true;
    }
    __device__ __forceinline__ void a_ready(const Unit&) const {}
    __device__ __forceinline__ void done(const Unit&) const {}
};

typedef float f32x2 __attribute__((ext_vector_type(2)));
__device__ __forceinline__ f32x2 gelu_pk(f32x2 v) {
    const f32x2 av = __builtin_elementwise_abs(v), d = av * 0.2316418882f + 1.0f;
    f32x2 t; t.x = __builtin_amdgcn_rcpf(d.x); t.y = __builtin_amdgcn_rcpf(d.y);
    f32x2 q = t * 0.5307027145f + (-0.7265760135f); q = q * t + 0.7107068705f; q = q * t + (-0.142248368f); q = q * t + 0.127414796f; q = q * t;
    const f32x2 s = (v * v) * (-0.72134752044f);
    f32x2 e; e.x = __builtin_amdgcn_exp2f(s.x); e.y = __builtin_amdgcn_exp2f(s.y);
    const f32x2 m = v * (q * e), r = v - m;
    f32x2 o; o.x = v.x < 0.f ? m.x : r.x; o.y = v.y < 0.f ? m.y : r.y; return o;
}
typedef __bf16 bf16x2_t __attribute__((ext_vector_type(2)));
__device__ __forceinline__ unsigned pk_bf16(float lo, float hi) { const f32x2 f = {lo, hi}; return __builtin_bit_cast(unsigned, __builtin_convertvector(f, bf16x2_t)); }
__device__ __forceinline__ float silu_f(float v) { return v * __builtin_amdgcn_rcpf(1.0f + __builtin_amdgcn_exp2f(-1.44269504089f * v)); }
struct EpiIn {
    static constexpr bool PERM = true, AFTER_DRAIN = false;
    bf16_t *UG, *GV, *Z, *SGB; float* VSTP;
    __device__ __forceinline__ void operator()(const f32x4 (&acc)[2][2][4][2], const Unit& u, int wr, int wc, int fr, int fq) const {
        const int row0 = u.pm * BM + wr * 64 + fr, cl = wc * 32 + 8 * fq;
        if (u.pn < 4) {
            bf16_t* base = UG + (size_t)row0 * 512 + u.pn * 128 + cl;
#pragma unroll
            for (int ai = 0; ai < 2; ++ai)
#pragma unroll
                for (int m = 0; m < 4; ++m) {
                    const f32x4 a0 = acc[ai][0][m][0], a1 = acc[ai][0][m][1], g0 = acc[ai][1][m][0], g1 = acc[ai][1][m][1];
                    const f32x2 p0 = gelu_pk((f32x2){a0[0], a0[1]}), p1 = gelu_pk((f32x2){a0[2], a0[3]}), p2 = gelu_pk((f32x2){a1[0], a1[1]}), p3 = gelu_pk((f32x2){a1[2], a1[3]});
                    u32x4 w;
                    w.x = pk_bf16(p0.x * silu_f(g0[0]), p0.y * silu_f(g0[1])); w.y = pk_bf16(p1.x * silu_f(g0[2]), p1.y * silu_f(g0[3]));
                    w.z = pk_bf16(p2.x * silu_f(g1[0]), p2.y * silu_f(g1[1])); w.w = pk_bf16(p3.x * silu_f(g1[2]), p3.y * silu_f(g1[3]));
                    *(u32x4*)(base + (size_t)(ai * HALF + m * 16) * 512) = w;
                }
        } else if (u.pn < 6) {
            bf16_t* base = GV + (size_t)row0 * 512 + (u.pn - 4) * 256 + cl;
            float* sp = VSTP + (size_t)row0 * 16 + ((u.pn - 4) * 4 + wc) * 2;
#pragma unroll
            for (int ai = 0; ai < 2; ++ai)
#pragma unroll
                for (int m = 0; m < 4; ++m) {
                    float s = 0.f, q = 0.f;
#pragma unroll
                    for (int bj = 0; bj < 2; ++bj) {
                        const f32x4 a0 = acc[ai][bj][m][0], a1 = acc[ai][bj][m][1];
                        const f32x2 p0 = gelu_pk((f32x2){a0[0], a0[1]}), p1 = gelu_pk((f32x2){a0[2], a0[3]}), p2 = gelu_pk((f32x2){a1[0], a1[1]}), p3 = gelu_pk((f32x2){a1[2], a1[3]});
                        s += ((p0.x + p0.y) + (p1.x + p1.y)) + ((p2.x + p2.y) + (p3.x + p3.y));
                        q += ((p0.x * p0.x + p0.y * p0.y) + (p1.x * p1.x + p1.y * p1.y)) + ((p2.x * p2.x + p2.y * p2.y) + (p3.x * p3.x + p3.y * p3.y));
                        u32x4 w; w.x = pk_bf16(p0.x, p0.y); w.y = pk_bf16(p1.x, p1.y); w.z = pk_bf16(p2.x, p2.y); w.w = pk_bf16(p3.x, p3.y);
                        *(u32x4*)(base + (size_t)(ai * HALF + m * 16) * 512 + bj * HALF) = w;
                    }
                    s += __shfl_xor(s, 16); s += __shfl_xor(s, 32); q += __shfl_xor(q, 16); q += __shfl_xor(q, 32);
                    if (fq == 0) *(f32x2*)(sp + (size_t)(ai * HALF + m * 16) * 16) = (f32x2){s, q};
                }
        } else {
            const bool act = u.pn >= 8;
            bf16_t* base = (act ? SGB + (size_t)(u.pn - 8) * 256 : Z + (size_t)(u.pn - 6) * 256) + (size_t)row0 * 512 + cl;
#pragma unroll
            for (int ai = 0; ai < 2; ++ai)
#pragma unroll
                for (int m = 0; m < 4; ++m)
#pragma unroll
                    for (int bj = 0; bj < 2; ++bj) {
                        f32x4 a0 = acc[ai][bj][m][0], a1 = acc[ai][bj][m][1];
                        if (act) { a0 = (f32x4){silu_f(a0[0]), silu_f(a0[1]), silu_f(a0[2]), silu_f(a0[3])}; a1 = (f32x4){silu_f(a1[0]), silu_f(a1[1]), silu_f(a1[2]), silu_f(a1[3])}; }
                        u32x4 w; w.x = pk_bf16(a0[0], a0[1]); w.y = pk_bf16(a0[2], a0[3]); w.z = pk_bf16(a1[0], a1[1]); w.w = pk_bf16(a1[2], a1[3]);
                        *(u32x4*)(base + (size_t)(ai * HALF + m * 16) * 512 + bj * HALF) = w;
                    }
        }
    }
};
struct EpiY {
    static constexpr bool PERM = true, AFTER_DRAIN = false;
    bf16_t* Y; float* YSQ;
    __device__ __forceinline__ void operator()(const f32x4 (&acc)[2][2][4][2], const Unit& u, int wr, int wc, int fr, int fq) const {
        const int row0 = u.pm * BM + wr * 64 + fr, cl = wc * 32 + 8 * fq;
        bf16_t* base = Y + (size_t)row0 * 1024 + u.pn * 256 + cl;
        float* sp = YSQ + (size_t)row0 * 16 + u.pn * 4 + wc;
#pragma unroll
        for (int ai = 0; ai < 2; ++ai)
#pragma unroll
            for (int m = 0; m < 4; ++m) {
                float q = 0.f;
#pragma unroll
                for (int bj = 0; bj < 2; ++bj) {
                    const f32x4 a0 = acc[ai][bj][m][0], a1 = acc[ai][bj][m][1];
                    q += ((a0[0] * a0[0] + a0[1] * a0[1]) + (a0[2] * a0[2] + a0[3] * a0[3])) + ((a1[0] * a1[0] + a1[1] * a1[1]) + (a1[2] * a1[2] + a1[3] * a1[3]));
                    u32x4 w; w.x = pk_bf16(a0[0], a0[1]); w.y = pk_bf16(a0[2], a0[3]); w.z = pk_bf16(a1[0], a1[1]); w.w = pk_bf16(a1[2], a1[3]);
                    *(u32x4*)(base + (size_t)(ai * HALF + m * 16) * 1024 + bj * HALF) = w;
                }
                q += __shfl_xor(q, 16); q += __shfl_xor(q, 32);
                if (fq == 0) sp[(size_t)(ai * HALF + m * 16) * 16] = q;
            }
    }
};
struct PanelOrder {
    int G, c, nM, nN;
    __device__ __forceinline__ bool next(int i, Unit& u) const { const int pm = c + G * (i / nN); if (pm >= nM) return false; u.pm = pm; u.pn = i % nN; return true; }
    __device__ __forceinline__ void a_ready(const Unit&) const {}
    __device__ __forceinline__ void done(const Unit&) const {}
};


template <class Epi, class Sched, bool ALIGN_EPI = false, bool SP2 = false>
__device__ __forceinline__ void gemm_phase(PG8_LAS unsigned char* lds, const Gemm g, const Sched& S, const Epi& E) {
    const int tid = threadIdx.x, wid = __builtin_amdgcn_readfirstlane(tid >> 6), lane = tid & 63, wr = wid >> 2, wc = wid & 3, fr = lane & 15, fq = lane >> 4;
    const int K = g.K, nt = K / BK;
    unsigned voffA[2], voffB[2];
#pragma unroll
    for (int i = 0; i < 2; ++i) { int R, C; stage_rc(tid * 16 + i * 8192, R, C); const int Rb = Epi::PERM ? ((R & ~31) + perm32(R & 31)) : R;
        voffA[i] = (unsigned)(R * K + C) * 2u; voffB[i] = (unsigned)(Rb * K + C) * 2u; }
    const size_t kstep = (size_t)(BK * 2);
    const size_t hstep = (size_t)HALF * K * 2;
    const size_t tstep = 2 * hstep;
    const unsigned ldsw = (unsigned)wid * 1024u;
    const int aoff = lds_byte(wr * 64 + fr, fq * 8), boff = lds_byte(wc * 32 + fr, fq * 8);
#define PG8_SA(b, h) (((b) * 2 + (h)) * HTB)
#define PG8_SB(b, h) ((4 + (b) * 2 + (h)) * HTB)
#define PG8_STAGE(bufoff, gbase, voff) do { _Pragma("unroll") for (int _i = 0; _i < 2; ++_i) \
        __builtin_amdgcn_global_load_lds((const unsigned*)((const char*)(gbase) + (voff)[_i]), (PG8_LAS unsigned*)(lds + (bufoff) + ldsw + _i * 8192), 16, 0, 0); } while (0)
#define PG8_LDA(dst, b, h) do { _Pragma("unroll") for (int m = 0; m < 4; ++m) _Pragma("unroll") for (int k = 0; k < 2; ++k) dst[m][k] = *(const PG8_LAS bf16x8*)(lds + PG8_SA(b, h) + aoff + m * 2048 + k * 1024); } while (0)
#define PG8_LDB(dst, b, h) do { _Pragma("unroll") for (int n = 0; n < 2; ++n) _Pragma("unroll") for (int k = 0; k < 2; ++k) dst[n][k] = *(const PG8_LAS bf16x8*)(lds + PG8_SB(b, h) + boff + n * 2048 + k * 1024); } while (0)
#define PG8_MMA(ai, bj, At, Bt) do { __builtin_amdgcn_s_setprio(1); _Pragma("unroll") for (int m = 0; m < 4; ++m) _Pragma("unroll") for (int n = 0; n < 2; ++n) _Pragma("unroll") for (int k = 0; k < 2; ++k) \
        acc[ai][bj][m][n] = __builtin_amdgcn_mfma_f32_16x16x32_bf16(Bt[n][k], At[m][k], acc[ai][bj][m][n], 0, 0, 0); __builtin_amdgcn_s_setprio(0); } while (0)
#define PG8_WAIT_V(n) asm volatile("s_waitcnt vmcnt(" #n ")" ::: "memory")
#define PG8_WAIT_L(n) asm volatile("s_waitcnt lgkmcnt(" #n ")" ::: "memory")
#define PG8_BAR __builtin_amdgcn_s_barrier()
#define PG8_SCHED __builtin_amdgcn_sched_barrier(0)
    Unit cur, nxt; int ui = 0;
    if (!S.next(0, cur)) return;
    f32x4 acc[2][2][4][2];
#pragma unroll
    for (int a = 0; a < 2; ++a)
#pragma unroll
        for (int b = 0; b < 2; ++b)
#pragma unroll
            for (int m = 0; m < 4; ++m)
#pragma unroll
                for (int n = 0; n < 2; ++n) acc[a][b][m][n] = (f32x4){0.f, 0.f, 0.f, 0.f};
    bf16x8 At[4][2], B0[2][2], B1[2][2];
    const char* cA = (const char*)g.A + (size_t)cur.pm * tstep; const char* cB = (const char*)g.Bt + (size_t)cur.pn * tstep;
    S.a_ready(cur);
    if constexpr (SP2) {
        PG8_STAGE(PG8_SB(0, 0), cB, voffB); PG8_STAGE(PG8_SB(0, 1), cB + hstep, voffB); PG8_STAGE(PG8_SA(0, 0), cA, voffA); PG8_STAGE(PG8_SA(0, 1), cA + hstep, voffA);
        if (wr == 1) PG8_BAR;
        PG8_WAIT_V(2); PG8_BAR;
        PG8_STAGE(PG8_SB(1, 0), cB + kstep, voffB); PG8_STAGE(PG8_SA(1, 0), cA + kstep, voffA); PG8_STAGE(PG8_SB(1, 1), cB + hstep + kstep, voffB);
        PG8_WAIT_V(6); PG8_BAR;
    } else {
        PG8_STAGE(PG8_SB(0, 0), cB, voffB); PG8_STAGE(PG8_SA(0, 0), cA, voffA); PG8_STAGE(PG8_SB(0, 1), cB + hstep, voffB); PG8_STAGE(PG8_SA(0, 1), cA + hstep, voffA);
        if (wr == 1) PG8_BAR;
        PG8_WAIT_V(4); PG8_BAR;
        PG8_STAGE(PG8_SB(1, 0), cB + kstep, voffB); PG8_STAGE(PG8_SA(1, 0), cA + kstep, voffA); PG8_STAGE(PG8_SB(1, 1), cB + hstep + kstep, voffB);
        PG8_WAIT_V(6); PG8_BAR;
    }
    for (;;) {
        const bool has_next = S.next(ui + 1, nxt);
        const char* nA = has_next ? (const char*)g.A + (size_t)nxt.pm * tstep : cA; const char* nB = has_next ? (const char*)g.Bt + (size_t)nxt.pn * tstep : cB;
        for (int t = 0; t < nt; t += 2) {
            const bool last = (t == nt - 2);
            const char* a1 = cA + (size_t)(t + 1) * kstep;
            const char* a2 = last ? nA : cA + (size_t)(t + 2) * kstep; const char* b2 = last ? nB : cB + (size_t)(t + 2) * kstep;
            const char* a3 = a2 + kstep; const char* b3 = b2 + kstep;
            if (last && has_next) S.a_ready(nxt);
            if constexpr (SP2) {
            PG8_LDB(B0, 0, 0); PG8_LDB(B1, 0, 1); PG8_SCHED; PG8_LDA(At, 0, 0); PG8_STAGE(PG8_SA(1, 1), a1 + hstep, voffA);
            PG8_WAIT_V(8); PG8_WAIT_L(0); PG8_BAR; PG8_MMA(0, 0, At, B0); PG8_MMA(0, 1, At, B1); PG8_BAR; PG8_SCHED;
            PG8_LDA(At, 0, 1); PG8_STAGE(PG8_SB(0, 0), b2, voffB); PG8_STAGE(PG8_SB(0, 1), b2 + hstep, voffB); PG8_STAGE(PG8_SA(0, 0), a2, voffA);
            PG8_WAIT_V(8); PG8_WAIT_L(0); PG8_BAR; PG8_MMA(1, 0, At, B0); PG8_MMA(1, 1, At, B1); PG8_BAR; PG8_SCHED;
            PG8_LDB(B0, 1, 0); PG8_LDB(B1, 1, 1); PG8_SCHED; PG8_LDA(At, 1, 0); PG8_STAGE(PG8_SA(0, 1), a2 + hstep, voffA);
            PG8_WAIT_V(8); PG8_WAIT_L(0); PG8_BAR; PG8_MMA(0, 0, At, B0); PG8_MMA(0, 1, At, B1); PG8_BAR; PG8_SCHED;
            PG8_LDA(At, 1, 1); PG8_STAGE(PG8_SB(1, 0), b3, voffB); PG8_STAGE(PG8_SB(1, 1), b3 + hstep, voffB); PG8_STAGE(PG8_SA(1, 0), a3, voffA);
            PG8_WAIT_V(8); PG8_WAIT_L(0); PG8_BAR; PG8_MMA(1, 0, At, B0); PG8_MMA(1, 1, At, B1); PG8_BAR; PG8_SCHED;
            } else {
            PG8_LDB(B0, 0, 0); PG8_SCHED; PG8_LDA(At, 0, 0); PG8_STAGE(PG8_SA(1, 1), a1 + hstep, voffA);
            PG8_WAIT_L(8); PG8_BAR; PG8_WAIT_L(0); PG8_MMA(0, 0, At, B0); PG8_BAR; PG8_SCHED;
            PG8_LDB(B1, 0, 1); PG8_STAGE(PG8_SB(0, 0), b2, voffB);
            PG8_BAR; PG8_WAIT_L(0); PG8_MMA(0, 1, At, B1); PG8_BAR;
            PG8_LDA(At, 0, 1); PG8_STAGE(PG8_SA(0, 0), a2, voffA);
            PG8_BAR; PG8_WAIT_L(0); PG8_MMA(1, 0, At, B0); PG8_BAR; PG8_SCHED;
            PG8_STAGE(PG8_SB(0, 1), b2 + hstep, voffB);
            PG8_WAIT_V(6); PG8_BAR; PG8_MMA(1, 1, At, B1); PG8_BAR;
            PG8_LDB(B0, 1, 0); PG8_SCHED; PG8_LDA(At, 1, 0); PG8_STAGE(PG8_SA(0, 1), a2 + hstep, voffA);
            PG8_WAIT_L(8); PG8_BAR; PG8_WAIT_L(0); PG8_MMA(0, 0, At, B0); PG8_BAR; PG8_SCHED;
            PG8_LDB(B1, 1, 1); PG8_STAGE(PG8_SB(1, 0), b3, voffB);
            PG8_BAR; PG8_WAIT_L(0); PG8_MMA(0, 1, At, B1); PG8_BAR;
            PG8_LDA(At, 1, 1); PG8_STAGE(PG8_SA(1, 0), a3, voffA);
            PG8_BAR; PG8_WAIT_L(0); PG8_MMA(1, 0, At, B0); PG8_BAR; PG8_SCHED;
            PG8_STAGE(PG8_SB(1, 1), b3 + hstep, voffB);
            PG8_WAIT_V(6); PG8_BAR; PG8_MMA(1, 1, At, B1); PG8_BAR;
            }
        }
        if constexpr (ALIGN_EPI) { if (wr == 0) PG8_BAR; }
        if constexpr (!Epi::AFTER_DRAIN) { E(acc, cur, wr, wc, fr, fq); S.done(cur); }
        if (!has_next) break;
#pragma unroll
        for (int a = 0; a < 2; ++a)
#pragma unroll
            for (int b = 0; b < 2; ++b)
#pragma unroll
                for (int m = 0; m < 4; ++m)
#pragma unroll
                    for (int n = 0; n < 2; ++n) acc[a][b][m][n] = (f32x4){0.f, 0.f, 0.f, 0.f};
        cur = nxt; cA = nA; cB = nB; ++ui;
        if constexpr (ALIGN_EPI) { if (wr == 1) PG8_BAR; }
    }
    PG8_WAIT_V(0);
    if constexpr (!ALIGN_EPI) { if (wr == 0) PG8_BAR; }
    PG8_BAR;
    if constexpr (Epi::AFTER_DRAIN) { E.fused(acc, cur, wr, wc, fr, fq, lds, wid, lane); S.done(cur); }
#undef PG8_SA
#undef PG8_SB
#undef PG8_STAGE
#undef PG8_LDA
#undef PG8_LDB
#undef PG8_MMA
#undef PG8_WAIT_V
#undef PG8_WAIT_L
#undef PG8_BAR
#undef PG8_SCHED
}
}
constexpr int NWAVES = 8;
#ifndef MK_N_LAUNCHES
#define MK_N_LAUNCHES 1
#endif
constexpr int N_LAUNCHES = MK_N_LAUNCHES;
constexpr int PER_PHASE = 5;
#ifndef PROBE_REPEAT
#define PROBE_REPEAT -1
#endif

constexpr int BATCH = 32, SEQ = 2048, D = 1024, DA = 512, DB = 512, DIN = 2560;
constexpr int M = BATCH * SEQ;
constexpr float EPS = 1e-6f;

constexpr size_t MiB = 1u << 20;
constexpr size_t WS_CTL = 0, CTL_ZERO_BYTES = 1 * MiB;
constexpr size_t WS_WIN = 2 * MiB;
constexpr size_t WS_WOUT = 8 * MiB;
constexpr size_t WS_WSB = 10 * MiB;
constexpr size_t WS_MT = 11 * MiB;
constexpr size_t WS_ECS = 12 * MiB;
constexpr size_t WS_MTF = 13 * MiB;
constexpr size_t WS_VSTP = 14 * MiB;
constexpr size_t WS_YSQ = 18 * MiB;
constexpr size_t WS_H = 32 * MiB;
constexpr size_t WS_UG = 160 * MiB;
constexpr size_t WS_GV = 224 * MiB;
constexpr size_t WS_Z = 288 * MiB;
constexpr size_t WS_SGB = 352 * MiB;
constexpr size_t WS_X1 = 416 * MiB;
constexpr size_t WS_A2 = 480 * MiB;
constexpr size_t WS_Y = 608 * MiB;
constexpr size_t WS_END = 736 * MiB;
constexpr int CW_TMO = 0, CW_CODE = 1, CW_BAR = 4096;

constexpr int RING_OFF = 0, RING_BYTES = 131072;
constexpr int LDSCTL_OFF = RING_BYTES, MISC_OFF = LDSCTL_OFF + 320;
constexpr int LDS_BYTES = 147456;
static_assert(MISC_OFF + 128 <= LDS_BYTES, "LDS map");


#define GAS __attribute__((address_space(1)))
#define LAS __attribute__((address_space(3)))
typedef unsigned short bf16;
typedef unsigned v4u __attribute__((ext_vector_type(4)));
typedef float f32x4 __attribute__((ext_vector_type(4)));
typedef short bf16x8 __attribute__((ext_vector_type(8)));
typedef GAS unsigned gu32;
typedef GAS unsigned long long gu64;
#define RLX_AGENT __ATOMIC_RELAXED, __HIP_MEMORY_SCOPE_AGENT
#define LDS_WAIT() asm volatile("s_waitcnt lgkmcnt(0)" ::: "memory")
#define VM_WAIT() asm volatile("s_waitcnt vmcnt(0)" ::: "memory")
__device__ __forceinline__ unsigned long long rt() { return __builtin_amdgcn_s_memrealtime(); }
__device__ __forceinline__ unsigned f2bf(float f) { unsigned u = __builtin_bit_cast(unsigned, f); return (u + 0x7fffu + ((u >> 16) & 1u)) >> 16; }
__device__ __forceinline__ unsigned pk2(float lo, float hi) { return f2bf(lo) | (f2bf(hi) << 16); }
#define XB_TMO      128
#define XB_XCNT(j)  (256  + 64 * (j))
#define XB_XSUB(j)  (1280 + 64 * (j))
#define XB_XGEN(j)  (2304 + 64 * (j))
#define XB_TOP      3328
#define XB_TOPGEN   3392
#define XCD_BAR_WORDS 3456
#define XB_SPIN_CAP (1u << 18)

__device__ __forceinline__ unsigned xb_ld(unsigned* p)              { return __hip_atomic_load(p, __ATOMIC_RELAXED, __HIP_MEMORY_SCOPE_AGENT); }
__device__ __forceinline__ unsigned xb_add(unsigned* p, unsigned v) { return __hip_atomic_fetch_add(p, v, __ATOMIC_RELAXED, __HIP_MEMORY_SCOPE_AGENT); }
__device__ __forceinline__ unsigned xb_xcc_id() { return (unsigned)__builtin_amdgcn_s_getreg((3 << 11) | 20) & 0xFu; }
#define XB_SPIN(cond, bar) do { unsigned _sp = 0; while (cond) { __builtin_amdgcn_s_sleep(1); \
    if ((++_sp & 255u) == 0u) { if (xb_ld(&(bar)[XB_TMO])) break; if (_sp > XB_SPIN_CAP) { atomicAdd(&(bar)[XB_TMO], 1u); break; } } } } while (0)

struct XcdBarrier {
    unsigned* bar; unsigned x;
    volatile LAS unsigned* st;
};

__device__ __forceinline__ XcdBarrier xcd_barrier_post(unsigned* bar, volatile LAS unsigned* st) {
    XcdBarrier b; b.bar = bar; b.x = xb_xcc_id(); b.st = st;
    if (threadIdx.x == 0) (void)xb_add(&bar[XB_XCNT(b.x)], 1u);
    return b;
}
__device__ __forceinline__ void xcd_barrier_complete(unsigned* bar, unsigned x, unsigned& nloc, unsigned& nx) {
    const unsigned G = gridDim.x * gridDim.y * gridDim.z;
    unsigned sum, cnt, mine, sp = 0u;
    for (;;) {
        sum = 0u; cnt = 0u; mine = 0u;
#pragma unroll
        for (unsigned j = 0; j < 16; ++j) { const unsigned c = xb_ld(&bar[XB_XCNT(j)]); sum += c; cnt += (c > 0u) ? 1u : 0u; mine = (j == x) ? c : mine; }
        if (sum == G) break;
        __builtin_amdgcn_s_sleep(1);
        if ((++sp & 255u) == 0u) { if (xb_ld(&bar[XB_TMO])) break; if (sp > XB_SPIN_CAP) { atomicAdd(&bar[XB_TMO], 1u); break; } }
    }
    nloc = mine > 0u ? mine : 1u; nx = cnt > 0u ? cnt : 1u;
}

__device__ __forceinline__ void xcd_barrier(const XcdBarrier& b) {
    asm volatile("s_waitcnt vmcnt(0)" ::: "memory");
    __syncthreads();
    if (threadIdx.x == 0) {
        unsigned* bar = b.bar;
        __builtin_amdgcn_s_waitcnt(0);
        unsigned nloc = b.st[0], nx = b.st[1];
        if (nloc == 0u) { xcd_barrier_complete(bar, b.x, nloc, nx); b.st[0] = nloc; b.st[1] = nx; }
        const unsigned old = xb_add(&bar[XB_XSUB(b.x)], 1u);
        const unsigned gen = old / nloc;
        if (old + 1u == (gen + 1u) * nloc) {
            __builtin_amdgcn_fence(__ATOMIC_RELEASE, "agent");
            asm volatile("s_waitcnt vmcnt(0)" ::: "memory");
            const unsigned og = xb_add(&bar[XB_TOP], 1u);
            const unsigned tg = og / nx;
            if (og + 1u == (tg + 1u) * nx) xb_add(&bar[XB_TOPGEN], 1u);
            else XB_SPIN(xb_ld(&bar[XB_TOPGEN]) == tg, bar);
            __builtin_amdgcn_fence(__ATOMIC_ACQUIRE, "agent");
            xb_add(&bar[XB_XGEN(b.x)], 1u);
            asm volatile("s_waitcnt vmcnt(0)" ::: "memory");
        } else {
            XB_SPIN(xb_ld(&bar[XB_XGEN(b.x)]) == gen, bar);
            __builtin_amdgcn_fence(__ATOMIC_ACQUIRE, "agent");
            asm volatile("s_waitcnt vmcnt(0)" ::: "memory");
        }
    }
    __syncthreads();
}
typedef float f32x2 __attribute__((ext_vector_type(2)));
typedef float f32x16 __attribute__((ext_vector_type(16)));
typedef unsigned u32x2 __attribute__((ext_vector_type(2)));
using pg8::pk_bf16;
struct Frame {
    LAS unsigned char* lds;
    volatile LAS unsigned* MISC;
    gu32* ctl;
    int tid, lane, wave;
    int vcu, G;
    const float *x, *pre_g, *post_g, *w_in, *ln_g, *ln_b, *w_s, *b_s, *w_f, *b_f, *w_out; float* out;
    bf16 *WIN, *WOUT, *WSB, *MT, *MTF, *ECS, *H, *UG, *GV, *Z, *SGB, *X1, *A2, *Y;
    float *VSTP, *YSQ;
};
__device__ __forceinline__ float bflo(unsigned w) { return __builtin_bit_cast(float, w << 16); }
__device__ __forceinline__ float bfhi(unsigned w) { return __builtin_bit_cast(float, w & 0xffff0000u); }
__device__ __forceinline__ float wave_sum(float v) {
#pragma unroll
    for (int o = 1; o < 64; o <<= 1) v += __shfl_xor(v, o);
    return v;
}
__device__ __forceinline__ int win_src_col(int n) { const int t = n >> 8, r = n & 255; return t < 4 ? (r < 128 ? t * 128 + r : 1024 + t * 128 + (r - 128)) : (t < 6 ? 512 + (t - 4) * 256 + r : (t < 8 ? 1536 + (t - 6) * 256 + r : 2048 + (t - 8) * 256 + r)); }
__device__ __forceinline__ void p0_transpose_item(const float* W, int K, int N, bf16* WT, const float* kscale, bool remap, LAS float* scr, int item, int lane) {
    const int nblk = N / 32, kb = item / nblk, nb = item % nblk, k0 = 64 * kb, n0 = 32 * nb, s0 = remap ? win_src_col(n0) : n0;
#pragma unroll 8
    for (int i = 0; i < 32; ++i) { const int kk = 2 * i + (lane >> 5); float v = W[(size_t)(k0 + kk) * N + s0 + (lane & 31)]; if (kscale) v *= kscale[k0 + kk]; scr[kk * 33 + (lane & 31)] = v; }
    LDS_WAIT(); asm volatile("" ::: "memory");
    const int c = lane & 7;
#pragma unroll
    for (int j = 0; j < 4; ++j) { const int n = (lane >> 3) + 8 * j; const LAS float* s = scr + (8 * c) * 33 + n;
        v4u o; o.x = pk_bf16(s[0 * 33], s[1 * 33]); o.y = pk_bf16(s[2 * 33], s[3 * 33]); o.z = pk_bf16(s[4 * 33], s[5 * 33]); o.w = pk_bf16(s[6 * 33], s[7 * 33]);
        *(GAS v4u*)(WT + (size_t)(n0 + n) * K + k0 + 8 * c) = o; }
    LDS_WAIT(); asm volatile("" ::: "memory");
}
__device__ __forceinline__ void rms_rows4_to_bf16(Frame& F, const float* xrow, bf16* orow) {
    f32x4 v[4][4]; float s[4];
#pragma unroll
    for (int i = 0; i < 4; ++i) { const GAS f32x4* xr = (const GAS f32x4*)(xrow + (size_t)i * D) + F.lane;
#pragma unroll
        for (int j = 0; j < 4; ++j) v[i][j] = xr[64 * j]; }
#pragma unroll
    for (int i = 0; i < 4; ++i) { s[i] = 0.f;
#pragma unroll
        for (int j = 0; j < 4; ++j) s[i] += (v[i][j].x * v[i][j].x + v[i][j].y * v[i][j].y) + (v[i][j].z * v[i][j].z + v[i][j].w * v[i][j].w); }
#pragma unroll
    for (int o = 1; o < 64; o <<= 1) {
#pragma unroll
        for (int i = 0; i < 4; ++i) s[i] += __shfl_xor(s[i], o); }
#pragma unroll
    for (int i = 0; i < 4; ++i) { const float r = rsqrtf(s[i] * (1.f / D) + EPS); GAS u32x2* o8 = (GAS u32x2*)(orow + (size_t)i * D) + F.lane;
#pragma unroll
        for (int j = 0; j < 4; ++j) o8[64 * j] = (u32x2){pk_bf16(v[i][j].x * r, v[i][j].y * r), pk_bf16(v[i][j].z * r, v[i][j].w * r)}; }
}
__device__ __forceinline__ void p0_prologue(Frame& F) {
    LAS float* scr = (LAS float*)(F.lds + RING_OFF + F.wave * 16384);
    const int gw = F.vcu * NWAVES + F.wave, NGW = F.G * NWAVES;
    constexpr int I_IN = (D / 64) * (DIN / 32), I_OUT = (D / 64) * (D / 32);
    for (int it = gw; it < I_IN + I_OUT; it += NGW) {
        if (it < I_IN) p0_transpose_item(F.w_in, D, DIN, F.WIN, F.pre_g, true, scr, it, F.lane);
        else p0_transpose_item(F.w_out, D, D, F.WOUT, nullptr, false, scr, it - I_IN, F.lane);
    }
    const int gt = gw * 64 + F.lane, NT = NGW * 64;
    for (int i = gt; i < 4 * 128 * 128 / 2; i += NT) { const f32x2 v = *(const f32x2*)(F.w_s + 2 * i); ((unsigned*)F.WSB)[i] = pk_bf16(v.x, v.y); }
    for (int i = gt; i < 16 * 4 * 16 * 64; i += NT) {
        const int ln = i & 63, scs = (i >> 6) & 15, kt = (i >> 10) & 3, k1 = i >> 12, k2 = 32 * kt + (ln & 31), h = ln >> 5, st = scs >> 2, c = (scs >> 1) & 1, s = scs & 1;
        float v[8];
#pragma unroll
        for (int j = 0; j < 8; ++j) { const int sl = 32 * st + 16 * s + 8 * (j >> 2) + 4 * h + (j & 3); const int idx = ((k1 + 16 * k2) * sl) & 2047; float sn, cs; sincospif((float)idx * (1.0f / 1024.0f), &sn, &cs); v[j] = c ? sn : cs; }
        v4u o; o.x = pk_bf16(v[0], v[1]); o.y = pk_bf16(v[2], v[3]); o.z = pk_bf16(v[4], v[5]); o.w = pk_bf16(v[6], v[7]);
        *(v4u*)(F.ECS + (size_t)i * 8) = o;
    }
    {   LAS float* ctab = (LAS float*)(F.lds + RING_OFF + F.wave * 16384 + 12288);
        { float sn, cs; sincospif((float)F.lane * (1.0f / 64.0f), &sn, &cs); ctab[F.lane] = cs; ctab[64 + F.lane] = -cs; }
        LDS_WAIT(); asm volatile("" ::: "memory");
        for (int i = gt; i < 4 * 128 * 128; i += NT) {
            const int c = i & 127, e = (i >> 7) & 127, g = i >> 14; float wc = 0.f, ws = 0.f; const float* wf = F.w_f + (size_t)g * 16384 + e;
#pragma unroll 8
            for (int m = 0; m < 128; ++m) { const int ph = (c * m) & 127; const float w = wf[(size_t)m * 128]; wc += ctab[ph] * w; ws += ctab[(ph + 96) & 127] * w; }
            wc *= (1.0f / 512.0f); ws *= (1.0f / 512.0f);
            unsigned short* mt = (unsigned short*)F.MT + (size_t)g * 65536;
            const unsigned pc = pk_bf16(wc, -ws);
            mt[(size_t)e * 256 + c] = (unsigned short)pc; mt[(size_t)e * 256 + 128 + c] = (unsigned short)(pk_bf16(ws, 0.f));
            mt[(size_t)(128 + e) * 256 + c] = (unsigned short)(pc >> 16); mt[(size_t)(128 + e) * 256 + 128 + c] = (unsigned short)pc;
        }
        LDS_WAIT(); asm volatile("" ::: "memory");
    }
    for (int m = 4 * gw; m < M; m += 4 * NGW) rms_rows4_to_bf16(F, F.x + (size_t)m * D, F.H + (size_t)m * D);
}

__device__ __forceinline__ int lnt_key(int c) { return ((c ^ (c >> 5)) & 1) | (((c >> 3) & 3) << 1) | (((c >> 1) & 1) << 3); }
__device__ __forceinline__ int lnt_off(int c, int qchunk) { return c * 256 + ((qchunk ^ lnt_key(c)) << 4); }
__device__ __forceinline__ void p2_spatial_all(Frame& F) {
    const int tid = F.tid, lane = F.lane, w = F.wave;
    LAS float* st_mu = (LAS float*)(F.lds + 65536);
    LAS float* st_rs = st_mu + 256;
    const int nch = ((int)blockIdx.x + F.G < 512) ? 2 : (((int)blockIdx.x < 512) ? 1 : 0);
    if (nch == 0) return;
    if (tid < 128 * nch) {
        const int cc = tid >> 7, q = tid & 127; const float* sp = F.VSTP + (size_t)(((int)blockIdx.x + cc * F.G) * 128 + q) * 16; float sm = 0.f, qq = 0.f;
#pragma unroll
        for (int i = 0; i < 8; ++i) { sm += sp[2 * i]; qq += sp[2 * i + 1]; }
        const float mu = sm * (1.f / DA), var = fmaxf(qq * (1.f / DA) - mu * mu, 0.f);
        st_mu[tid] = mu; st_rs[tid] = rsqrtf(var + EPS);
    }
    const int cg = lane & 15, tq = lane >> 4, q0 = 16 * w + 4 * tq;
    const int fr = lane & 15, fq = lane >> 4, wcb = (w & 3) * 32, ph = (w >> 2) * 64;
    const int nit = 4 * nch;
    v4u raw[4], ug[4]; bf16x8 wsf[4][4];
#define SP_M0(n) ((((int)blockIdx.x) + ((n) % nch) * F.G) * 128)
#define SP_LDRAW(n) do { const int h_ = (n) / nch, m0_ = SP_M0(n); _Pragma("unroll") for (int i = 0; i < 4; ++i) raw[i] = *(const v4u*)(F.GV + (size_t)(m0_ + q0 + i) * 512 + h_ * 128 + 8 * cg); } while (0)
    SP_LDRAW(0);
    __syncthreads();
#pragma unroll 1
    for (int n = 0; n < nit; ++n) {
        const int h = n / nch, cc = n % nch, m0 = SP_M0(n);
        LAS unsigned char* lnt = F.lds + (n & 1) * 32768;
        {
            float mu4[4], rs4[4];
#pragma unroll
            for (int i = 0; i < 4; ++i) { mu4[i] = st_mu[cc * 128 + q0 + i]; rs4[i] = st_rs[cc * 128 + q0 + i]; }
            const f32x4 g0 = *(const f32x4*)(F.ln_g + h * 128 + 8 * cg), g1 = *(const f32x4*)(F.ln_g + h * 128 + 8 * cg + 4);
            const f32x4 b0 = *(const f32x4*)(F.ln_b + h * 128 + 8 * cg), b1 = *(const f32x4*)(F.ln_b + h * 128 + 8 * cg + 4);
#pragma unroll
            for (int j = 0; j < 8; ++j) {
                const float gg = j < 4 ? g0[j & 3] : g1[j & 3], bb = j < 4 ? b0[j & 3] : b1[j & 3];
                float v[4];
#pragma unroll
                for (int i = 0; i < 4; ++i) { const unsigned wd = raw[i][j >> 1]; const float xv = (j & 1) ? bfhi(wd) : bflo(wd); v[i] = (xv - mu4[i]) * rs4[i] * gg + bb; }
                const int c = 8 * cg + j;
                *(LAS u32x2*)(lnt + lnt_off(c, q0 >> 3) + (q0 & 7) * 2) = (u32x2){pk_bf16(v[0], v[1]), pk_bf16(v[2], v[3])};
            }
        }
        if (n + 1 < nit) SP_LDRAW(n + 1);
#pragma unroll
        for (int t = 0; t < 4; ++t) ug[t] = *(const v4u*)(F.UG + (size_t)(m0 + ph + 16 * t + fr) * 512 + h * 128 + wcb + 8 * fq);
        if (cc == 0) {
#pragma unroll
            for (int t = 0; t < 4; ++t)
#pragma unroll
                for (int ks = 0; ks < 4; ++ks) wsf[t][ks] = *(const bf16x8*)(F.WSB + (size_t)(h * 128 + ph + 16 * t + fr) * 128 + 32 * ks + 8 * fq);
        }
        __syncthreads();
        f32x4 acc[2][4];
#pragma unroll
        for (int nn = 0; nn < 2; ++nn)
#pragma unroll
            for (int t = 0; t < 4; ++t) acc[nn][t] = (f32x4){0.f, 0.f, 0.f, 0.f};
#pragma unroll
        for (int ks = 0; ks < 4; ++ks) {
            bf16x8 a[2];
#pragma unroll
            for (int nn = 0; nn < 2; ++nn) { const int c = wcb + 8 * (fr >> 2) + 4 * nn + (fr & 3); a[nn] = *(const LAS bf16x8*)(lnt + lnt_off(c, 4 * ks + fq)); }
#pragma unroll
            for (int t = 0; t < 4; ++t)
#pragma unroll
                for (int nn = 0; nn < 2; ++nn) acc[nn][t] = __builtin_amdgcn_mfma_f32_16x16x32_bf16(a[nn], wsf[t][ks], acc[nn][t], 0, 0, 0);
        }
#pragma unroll
        for (int t = 0; t < 4; ++t) {
            const int p = ph + 16 * t + fr; const float bs = F.b_s[h * 128 + p]; const v4u u4 = ug[t];
            v4u o;
            o.x = pk_bf16((acc[0][t][0] + bs) * bflo(u4.x), (acc[0][t][1] + bs) * bfhi(u4.x)); o.y = pk_bf16((acc[0][t][2] + bs) * bflo(u4.y), (acc[0][t][3] + bs) * bfhi(u4.y));
            o.z = pk_bf16((acc[1][t][0] + bs) * bflo(u4.z), (acc[1][t][1] + bs) * bfhi(u4.z)); o.w = pk_bf16((acc[1][t][2] + bs) * bflo(u4.w), (acc[1][t][3] + bs) * bfhi(u4.w));
            *(v4u*)(F.A2 + (size_t)(m0 + p) * 1024 + h * 128 + wcb + 8 * fq) = o;
        }
    }
#undef SP_M0
#undef SP_LDRAW
    __syncthreads();
}
__device__ __forceinline__ void dft16(const float (&z)[16], float (&r)[16]) {
    constexpr float C16[16] = {1.f, 0.92387953251f, 0.70710678119f, 0.38268343237f, 0.f, -0.38268343237f, -0.70710678119f, -0.92387953251f, -1.f, -0.92387953251f, -0.70710678119f, -0.38268343237f, 0.f, 0.38268343237f, 0.70710678119f, 0.92387953251f};
    float e[8], o[8];
#pragma unroll
    for (int s = 1; s < 8; ++s) { e[s] = z[s] + z[16 - s]; o[s] = z[s] - z[16 - s]; }
#pragma unroll
    for (int k = 0; k <= 8; ++k) { float a = (k & 1) ? z[0] - z[8] : z[0] + z[8];
#pragma unroll
        for (int s = 1; s < 8; ++s) a += C16[(k * s) & 15] * e[s];
        r[k] = a; }
#pragma unroll
    for (int k = 1; k < 8; ++k) { float a = 0.f;
#pragma unroll
        for (int s = 1; s < 8; ++s) a -= C16[(k * s + 12) & 15] * o[s];
        r[8 + k] = a; }
}
__device__ __forceinline__ size_t dft_item_off(const Frame& F, int n, bool out) {
    const int it = ((int)blockIdx.x + (n >> 1) * F.G) * 512 + F.tid, b = it >> 13, s_lo = (it >> 6) & 127;
    return ((size_t)(out ? b * 16 * 128 : b * 2048) + s_lo) * 512 + 8 * (F.tid & 63) + 4 * (n & 1);
}
__device__ __forceinline__ void dft_load(const Frame& F, int n, u32x2 (&dst)[16]) { const bf16* zp = F.Z + dft_item_off(F, n, false);
#pragma unroll
    for (int s = 0; s < 16; ++s) dst[s] = *(const u32x2*)(zp + (size_t)s * 128 * 512); }
__device__ __forceinline__ void dft_do(const Frame& F, int n, const u32x2 (&src)[16]) {
    u32x2 outp[16];
#pragma unroll
    for (int jp = 0; jp < 2; ++jp) { float zl[16], zh[16], rl[16], rh[16];
#pragma unroll
        for (int s = 0; s < 16; ++s) { zl[s] = bflo(src[s][jp]); zh[s] = bfhi(src[s][jp]); }
        dft16(zl, rl); dft16(zh, rh);
#pragma unroll
        for (int pl = 0; pl < 16; ++pl) outp[pl][jp] = pk_bf16(rl[pl], rh[pl]); }
    bf16* xp = F.X1 + dft_item_off(F, n, true);
#pragma unroll
    for (int pl = 0; pl < 16; ++pl) *(u32x2*)(xp + (size_t)pl * 128 * 512) = outp[pl];
}
__device__ __forceinline__ void p2_dft16_all(Frame& F) {
    const int nun = ((int)blockIdx.x + F.G < 512) ? 2 : (((int)blockIdx.x < 512) ? 1 : 0), nit = 2 * nun;
    if (nit == 0) return;
    u32x2 inA[16], inB[16];
    dft_load(F, 0, inA);
    if (nit == 4) {
        dft_load(F, 1, inB); dft_do(F, 0, inA); dft_load(F, 2, inA); dft_do(F, 1, inB); dft_load(F, 3, inB); dft_do(F, 2, inA); dft_do(F, 3, inB);
        return;
    }
#pragma unroll 1
    for (int n = 0; n < nit; n += 2) {
        dft_load(F, n + 1, inB);
        dft_do(F, n, inA);
        if (n + 2 < nit) dft_load(F, n + 2, inA);
        dft_do(F, n + 1, inB);
    }
}
__device__ __forceinline__ v4u pack8(const f32x16& x, int s) { v4u p; p.x = pk_bf16(x[8 * s], x[8 * s + 1]); p.y = pk_bf16(x[8 * s + 2], x[8 * s + 3]); p.z = pk_bf16(x[8 * s + 4], x[8 * s + 5]); p.w = pk_bf16(x[8 * s + 6], x[8 * s + 7]); return p; }
__device__ __forceinline__ void p3_unit_decode(int ui, int& b, int& k1) { b = ui >> 4; const int j = ui & 15; k1 = j < 8 ? j : (j == 8 ? 8 : 24 - j); }
__device__ __forceinline__ void p2_mtf(Frame& F) {
    const int gt = (F.vcu * NWAVES + F.wave) * 64 + F.lane, NT = F.G * NWAVES * 64;
    for (int i2 = gt; i2 < 2 * 32768; i2 += NT) { const int i = i2 & 32767, ln = i & 63, ks = (i >> 6) & 15, et = (i >> 10) & 3, c = (i >> 12) & 1, g = i >> 13;
        v4u t = *(const v4u*)(F.MT + ((size_t)(g * 256 + c * 128 + et * 32 + (ln & 31))) * 256 + 16 * ks + 8 * (ln >> 5));
        const unsigned fl = (i2 >= 32768 && ks >= 8) ? 0x80008000u : 0u; t.x ^= fl; t.y ^= fl; t.z ^= fl; t.w ^= fl;
        *(v4u*)(F.MTF + (size_t)i2 * 8) = t; }
}
__device__ __forceinline__ void p3_slab_dma(Frame& F, LAS unsigned char* slab, int b, int k1, int g) {
    const int k1p = k1 <= 8 ? k1 : 16 - k1; const bool has_im = (k1p != 0 && k1p != 8);
    const bf16* xr = F.X1 + ((size_t)(b * 16 + k1p) * 128) * 512 + g * 128; const bf16* xi = has_im ? F.X1 + ((size_t)(b * 16 + 8 + k1p) * 128) * 512 + g * 128 : xr;
    int ln = F.lane; asm volatile("" : "+v"(ln));
#pragma unroll
    for (int i = 0; i < 8; ++i) { const int pc = i * 8 + F.wave, row = 2 * pc + (ln >> 5), c = (ln & 31) ^ (row & 15);
        const bf16* src = (c >= 16 ? xi : xr) + (size_t)row * 512 + (c & 15) * 8;
        __builtin_amdgcn_global_load_lds((const unsigned*)src, (LAS unsigned*)(slab + pc * 1024), 16, 0, 0); }
}
__device__ __forceinline__ void p3_fourier_all(Frame& F) {
    LAS unsigned char* slab = F.lds; LAS unsigned char* xb = F.lds + 65536;
    const int lane = F.lane, w = F.wave, r = lane & 31, hh = lane >> 5;
    const int et1 = w & 3, c1 = w >> 2;
    const int kt2 = w & 3, eh2 = w >> 2;
    bf16x8 bm[16];
#define P3_LDBM16(gg, cj) do { _Pragma("unroll") for (int q_ = 0; q_ < 16; ++q_) bm[q_] = *(const bf16x8*)(F.MTF + (size_t)(cj) * 262144 + ((((size_t)(gg) * 2 + c1) * 4 + et1) * 16 + q_) * 512 + lane * 8); } while (0)
    bool first = true;
#pragma unroll 1
    for (int ui = blockIdx.x; ui < 512; ui += F.G) {
        int b, k1; p3_unit_decode(ui, b, k1);
        const int k1p = k1 <= 8 ? k1 : 16 - k1; const bool has_im = (k1p != 0 && k1p != 8);
        bf16x8 Ef[16];
#pragma unroll
        for (int scs = 0; scs < 16; ++scs) Ef[scs] = *(const bf16x8*)(F.ECS + ((((size_t)k1 * 4 + kt2) * 16 + scs) * 64 + lane) * 8);
        if (first) { p3_slab_dma(F, slab, b, k1, 0); P3_LDBM16(0, k1 > 8 ? 1 : 0); asm volatile("s_waitcnt vmcnt(0)" ::: "memory"); __syncthreads(); first = false; }
        const int k2 = 32 * kt2 + r;
#pragma unroll 1
        for (int g = 0; g < 4; ++g) {
#pragma unroll
            for (int pass = 0; pass < 2; ++pass) {
                f32x16 Dt[2];
#pragma unroll
                for (int a = 0; a < 2; ++a)
#pragma unroll
                    for (int i = 0; i < 16; ++i) Dt[a][i] = 0.f;
#pragma unroll
                for (int ks = 0; ks < 16; ++ks) {
                    if (ks < 8 || has_im) {
#pragma unroll
                        for (int sti = 0; sti < 2; ++sti) { const int row = 32 * (2 * pass + sti) + r; const bf16x8 ax = *(const LAS bf16x8*)(slab + row * 512 + (((2 * ks + hh) ^ (row & 15)) << 4));
                            Dt[sti] = __builtin_amdgcn_mfma_f32_32x32x16_bf16(ax, bm[ks], Dt[sti], 0, 0, 0); }
                    }
                }
#pragma unroll
                for (int sti = 0; sti < 2; ++sti)
#pragma unroll
                    for (int s = 0; s < 2; ++s) *(LAS v4u*)(xb + (((((2 * pass + sti) * 2 + c1) * 2 + s) * 4 + et1) << 10) + lane * 16) = pack8(Dt[sti], s);
            }
            __syncthreads();
            const bool nxt_unit = (g == 3), has_next = !nxt_unit || (ui + F.G < 512);
            if (has_next) { int nb = b, nk1 = k1; if (nxt_unit) p3_unit_decode(ui + F.G, nb, nk1); p3_slab_dma(F, slab, nb, nk1, nxt_unit ? 0 : g + 1); }
            f32x16 Yt[2];
#pragma unroll
            for (int a = 0; a < 2; ++a)
#pragma unroll
                for (int i = 0; i < 16; ++i) Yt[a][i] = 0.f;
#pragma unroll
            for (int scs = 0; scs < 16; ++scs)
#pragma unroll
                for (int eti = 0; eti < 2; ++eti) { const bf16x8 df = *(const LAS bf16x8*)(xb + ((scs * 4 + 2 * eh2 + eti) << 10) + lane * 16);
                    Yt[eti] = __builtin_amdgcn_mfma_f32_32x32x16_bf16(df, Ef[scs], Yt[eti], 0, 0, 0); }
            int tidl = F.tid; asm volatile("" : "+v"(tidl));
            v4u sgq[4];
#pragma unroll
            for (int i = 0; i < 4; ++i) { const int cidx = i * 512 + tidl, rw = cidx >> 4, ch = cidx & 15; sgq[i] = *(const v4u*)(F.SGB + ((size_t)b * 2048 + k1 + 16 * rw) * 512 + g * 128 + ch * 8); }
            __syncthreads();
#pragma unroll
            for (int eti = 0; eti < 2; ++eti)
#pragma unroll
                for (int qd = 0; qd < 4; ++qd) { const int el = (2 * eh2 + eti) * 32 + 8 * qd + 4 * hh; const f32x4 bias = *(const f32x4*)(F.b_f + g * 128 + el);
                    const u32x2 o = {pk_bf16(Yt[eti][4 * qd + 0] + bias[0], Yt[eti][4 * qd + 1] + bias[1]), pk_bf16(Yt[eti][4 * qd + 2] + bias[2], Yt[eti][4 * qd + 3] + bias[3])};
                    *(LAS u32x2*)(xb + k2 * 256 + ((((el >> 3) ^ (k2 & 15)) << 4) | (hh << 3))) = o; }
            if (has_next) { int nb = b, nk1 = k1; if (nxt_unit) p3_unit_decode(ui + F.G, nb, nk1); P3_LDBM16(nxt_unit ? 0 : g + 1, nk1 > 8 ? 1 : 0); }
            __syncthreads();
#pragma unroll
            for (int i = 0; i < 4; ++i) { const int cidx = i * 512 + tidl, rw = cidx >> 4, ch = cidx & 15;
                const v4u yv = *(const LAS v4u*)(xb + rw * 256 + ((ch ^ (rw & 15)) << 4)); const v4u sv = sgq[i];
                v4u o; o.x = pk_bf16(bflo(yv.x) * bflo(sv.x), bfhi(yv.x) * bfhi(sv.x)); o.y = pk_bf16(bflo(yv.y) * bflo(sv.y), bfhi(yv.y) * bfhi(sv.y));
                o.z = pk_bf16(bflo(yv.z) * bflo(sv.z), bfhi(yv.z) * bfhi(sv.z)); o.w = pk_bf16(bflo(yv.w) * bflo(sv.w), bfhi(yv.w) * bfhi(sv.w));
                *(v4u*)(F.A2 + ((size_t)b * 2048 + k1 + 16 * rw) * 1024 + 512 + g * 128 + ch * 8) = o; }
            asm volatile("s_waitcnt vmcnt(0)" ::: "memory");
            __syncthreads();
        }
    }
#undef P3_LDBM16
}
__device__ __forceinline__ void p5_final_rows(Frame& F, int row0, int nrows) {
    const int lane = F.lane;
    f32x4 pg[4];
#pragma unroll
    for (int j = 0; j < 4; ++j) pg[j] = *(const f32x4*)(F.post_g + 4 * lane + 256 * j);
    for (int mb = row0 + 4 * F.wave; mb < row0 + nrows; mb += 4 * NWAVES) {
        float qv = F.YSQ[(size_t)mb * 16 + lane];
        u32x2 y[4][4]; f32x4 xv[4][4];
#pragma unroll
        for (int i = 0; i < 4; ++i) {
#pragma unroll
            for (int j = 0; j < 4; ++j) { y[i][j] = *(const u32x2*)(F.Y + (size_t)(mb + i) * D + 4 * lane + 256 * j); xv[i][j] = *(const f32x4*)(F.x + (size_t)(mb + i) * D + 4 * lane + 256 * j); } }
        qv += __shfl_xor(qv, 1); qv += __shfl_xor(qv, 2); qv += __shfl_xor(qv, 4); qv += __shfl_xor(qv, 8);
#pragma unroll
        for (int i = 0; i < 4; ++i) {
            const float rstd = rsqrtf(__shfl(qv, 16 * i) * (1.f / D) + EPS);
#pragma unroll
            for (int j = 0; j < 4; ++j) { const unsigned w0 = y[i][j].x, w1 = y[i][j].y;
                f32x4 o; o.x = xv[i][j].x + bflo(w0) * rstd * pg[j].x; o.y = xv[i][j].y + bfhi(w0) * rstd * pg[j].y; o.z = xv[i][j].z + bflo(w1) * rstd * pg[j].z; o.w = xv[i][j].w + bfhi(w1) * rstd * pg[j].w;
                *(f32x4*)(F.out + (size_t)(mb + i) * D + 4 * lane + 256 * j) = o; }
        }
    }
}

struct Args { const float* in[11]; float* out; unsigned char* ws; int ph_lo, ph_hi, li, pad; };
__global__ void __launch_bounds__(NWAVES * 64, 2) mega_fwd(Args args) {
    extern __shared__ __attribute__((aligned(16))) unsigned char lds[];
    Frame F;
    F.lds = (LAS unsigned char*)lds;
    F.MISC = (volatile LAS unsigned*)(F.lds + MISC_OFF);
    F.tid = threadIdx.x; F.lane = F.tid & 63; F.wave = __builtin_amdgcn_readfirstlane(F.tid >> 6);
    F.G = gridDim.x; { const int bx = blockIdx.x; F.vcu = (F.G % 8 == 0) ? (bx % 8) * (F.G / 8) + bx / 8 : bx; }
    unsigned char* ws = args.ws;
    F.ctl = (gu32*)(ws + WS_CTL);
    F.x = args.in[0]; F.pre_g = args.in[1]; F.post_g = args.in[2]; F.w_in = args.in[3]; F.ln_g = args.in[4]; F.ln_b = args.in[5]; F.w_s = args.in[6]; F.b_s = args.in[7];
    F.w_f = args.in[8]; F.b_f = args.in[9]; F.w_out = args.in[10]; F.out = args.out;
    F.WIN = (bf16*)(ws + WS_WIN); F.WOUT = (bf16*)(ws + WS_WOUT); F.WSB = (bf16*)(ws + WS_WSB); F.MT = (bf16*)(ws + WS_MT); F.MTF = (bf16*)(ws + WS_MTF); F.ECS = (bf16*)(ws + WS_ECS);
    F.H = (bf16*)(ws + WS_H); F.UG = (bf16*)(ws + WS_UG); F.GV = (bf16*)(ws + WS_GV); F.Z = (bf16*)(ws + WS_Z); F.SGB = (bf16*)(ws + WS_SGB); F.X1 = (bf16*)(ws + WS_X1);
    F.A2 = (bf16*)(ws + WS_A2); F.Y = (bf16*)(ws + WS_Y); F.VSTP = (float*)(ws + WS_VSTP); F.YSQ = (float*)(ws + WS_YSQ);
    for (int u = F.tid; u < (LDS_BYTES - LDSCTL_OFF) / 4; u += NWAVES * 64) ((LAS unsigned*)(F.lds + LDSCTL_OFF))[u] = 0u;
    __syncthreads();
    XcdBarrier bar; bar.bar = (unsigned*)(F.ctl + CW_BAR); bar.x = 0; bar.st = nullptr;
    if (N_LAUNCHES != PER_PHASE) bar = xcd_barrier_post((unsigned*)(F.ctl + CW_BAR), F.MISC + 8);
#define GRID_BAR() do { if (N_LAUNCHES != PER_PHASE) xcd_barrier(bar); } while (0)
    const int lo = args.ph_lo, hi = args.ph_hi;
#define IN(k) (lo <= (k) && (k) < hi)
#define BOTH(k) (IN(k) && IN((k) + 1))
    if (IN(0)) { p0_prologue(F); if (BOTH(0)) GRID_BAR(); }
    if (IN(1)) {
        pg8::Gemm g{F.H, F.WIN, M, DIN, D}; pg8::StaticOrder S; S.init(M, DIN, F.G, (int)blockIdx.x);
        pg8::EpiIn E{F.UG, F.GV, F.Z, F.SGB, F.VSTP};
        pg8::gemm_phase<pg8::EpiIn, pg8::StaticOrder, true, true>(F.lds + RING_OFF, g, S, E);
        if (BOTH(1)) GRID_BAR();
    }
    if (IN(2)) {
        p2_mtf(F);
        p2_spatial_all(F);
        p2_dft16_all(F);
        if (BOTH(2)) GRID_BAR();
    }
    if (IN(3)) {
        p3_fourier_all(F);
        if (BOTH(3)) GRID_BAR();
    }
    if (IN(4)) {
        pg8::Gemm g{F.A2, F.WOUT, M, D, D}; pg8::PanelOrder S{F.G, F.vcu, M / 256, D / 256};
        pg8::EpiY E{F.Y, F.YSQ};
        pg8::gemm_phase<pg8::EpiY, pg8::PanelOrder, true, true>(F.lds + RING_OFF, g, S, E);
        __builtin_amdgcn_fence(__ATOMIC_ACQUIRE, "agent");
        for (int pm = F.vcu; pm < M / 256; pm += F.G) p5_final_rows(F, pm * 256, 256);
    }
#undef IN
#undef BOTH
}

extern "C" void kernel_launch(void* const* d_in, const int* in_sizes, int n_in, void* d_out, int out_size, void* d_ws, size_t ws_size, hipStream_t stream) {
    static int grid = 0;
    if (grid == 0) {
        if (n_in != 11 || in_sizes[0] != M * D || out_size != M * D || ws_size < WS_END) { fprintf(stderr, "kernel_launch: unexpected shapes / workspace (n_in %d, in0 %d, out %d, ws %zu)\n", n_in, n_in > 0 ? in_sizes[0] : -1, out_size, ws_size); grid = -1; return; }
        int dev = 0, cus = 0, per_cu = 0;
        if (hipGetDevice(&dev) != hipSuccess || hipDeviceGetAttribute(&cus, hipDeviceAttributeMultiprocessorCount, dev) != hipSuccess) { grid = -1; return; }
        if (hipFuncSetAttribute((const void*)mega_fwd, hipFuncAttributeMaxDynamicSharedMemorySize, LDS_BYTES) != hipSuccess) { fprintf(stderr, "kernel_launch: hipFuncSetAttribute failed\n"); grid = -1; return; }
        if (hipOccupancyMaxActiveBlocksPerMultiprocessor(&per_cu, (const void*)mega_fwd, NWAVES * 64, LDS_BYTES) != hipSuccess || per_cu < 1) { fprintf(stderr, "kernel_launch: occupancy query says %d blocks per CU\n", per_cu); (void)hipGetLastError(); per_cu = 1; }
        grid = cus;
    }
    if (grid < 0) return;
    (void)hipMemsetAsync((char*)d_ws + WS_CTL, 0, CTL_ZERO_BYTES, stream);
    Args a; memset(&a, 0, sizeof(a));
    for (int i = 0; i < 11; ++i) a.in[i] = (const float*)d_in[i];
    a.out = (float*)d_out; a.ws = (unsigned char*)d_ws;
    for (int li = 0; li < N_LAUNCHES; ++li) {
        a.ph_lo = (N_LAUNCHES == PER_PHASE) ? li : 0; a.ph_hi = (N_LAUNCHES == PER_PHASE) ? li + 1 : PER_PHASE; a.li = li;
        hipLaunchKernelGGL(mega_fwd, dim3(grid), dim3(NWAVES * 64), LDS_BYTES, stream, a);
    }
    if (PROBE_REPEAT >= 0) { a.ph_lo = PROBE_REPEAT; a.ph_hi = PROBE_REPEAT + 1; a.li = 1; hipLaunchKernelGGL(mega_fwd, dim3(grid), dim3(NWAVES * 64), LDS_BYTES, stream, a); }
}
```

```cpp
#include <hip/hip_runtime.h>
#include <cstdio>
#include <cstdint>
#include <cstring>

namespace pg8 {
#define PG8_LAS __attribute__((address_space(3)))
typedef unsigned short bf16_t;
typedef short bf16x8 __attribute__((ext_vector_type(8)));
typedef float f32x4 __attribute__((ext_vector_type(4)));
typedef unsigned u32x4 __attribute__((ext_vector_type(4)));
constexpr int BM = 256, BK = 64, HALF = 128, HTB = HALF * BK * 2  , STAGE_BYTES = 8 * HTB, NXCD = 8, WGM = 8;

__host__ __device__ __forceinline__ int lds_byte(int r, int c) { const int st = (r >> 4) * 2 + (c >> 5), rr = r & 15, cc = c & 31, ob = rr * 64 + cc * 2; return st * 1024 + (ob ^ (((ob >> 9) & 1) << 5)); }
__host__ __device__ __forceinline__ void stage_rc(int b, int& R, int& C) { const int st = b / 1024, sb = b % 1024, swz = sb ^ (((sb >> 9) & 1) << 5); R = (st >> 1) * 16 + swz / 64; C = (st & 1) * 32 + (swz % 64) / 2; }
__host__ __device__ __forceinline__ int perm32(int rho) { const int n = rho >> 4, i = rho & 15; return 8 * (i >> 2) + 4 * n + (i & 3); }

struct Unit { int pm, pn; };
struct Gemm { const bf16_t* A; const bf16_t* Bt; int M, N, K; };

struct StaticOrder {
    int nM, nN, nwg, G, c;
    __host__ __device__ void init(int M, int N, int G_, int c_) { nM = M / BM; nN = N / BM; nwg = nM * nN; G = G_; c = c_; }
    __host__ __device__ bool next(int i, Unit& u) const {
        const long L = (long)i * G + c; if (L >= nwg) return false;
        int wgid = (int)L; { const int q = nwg / NXCD, r = nwg % NXCD, xcd = wgid % NXCD, off = wgid / NXCD; wgid = (xcd < r ? xcd * (q + 1) : r * (q + 1) + (xcd - r) * q) + off; }
        const int nig = WGM * nN, gid = wgid / nig, fm = gid * WGM, gsz = (nM - fm) < WGM ? (nM - fm) : WGM;
        u.pm = fm + ((wgid % nig) % gsz); u.pn = (wgid % nig) / gsz; return true;
    }
    __device__ __forceinline__ void a_ready(const Unit&) const {}
    __device__ __forceinline__ void done(const Unit&) const {}
};

typedef float f32x2 __attribute__((ext_vector_type(2)));
__device__ __forceinline__ f32x2 gelu_pk(f32x2 v) {
    const f32x2 av = __builtin_elementwise_abs(v), d = av * 0.2316418882f + 1.0f;
    f32x2 t; t.x = __builtin_amdgcn_rcpf(d.x); t.y = __builtin_amdgcn_rcpf(d.y);
    f32x2 q = t * 0.5307027145f + (-0.7265760135f); q = q * t + 0.7107068705f; q = q * t + (-0.142248368f); q = q * t + 0.127414796f; q = q * t;
    const f32x2 s = (v * v) * (-0.72134752044f);
    f32x2 e; e.x = __builtin_amdgcn_exp2f(s.x); e.y = __builtin_amdgcn_exp2f(s.y);
    const f32x2 m = v * (q * e), r = v - m;
    f32x2 o; o.x = v.x < 0.f ? m.x : r.x; o.y = v.y < 0.f ? m.y : r.y; return o;
}
typedef __bf16 bf16x2_t __attribute__((ext_vector_type(2)));
__device__ __forceinline__ unsigned pk_bf16(float lo, float hi) { const f32x2 f = {lo, hi}; return __builtin_bit_cast(unsigned, __builtin_convertvector(f, bf16x2_t)); }
__device__ __forceinline__ float silu_f(float v) { return v * __builtin_amdgcn_rcpf(1.0f + __builtin_amdgcn_exp2f(-1.44269504089f * v)); }
struct EpiIn {
    static constexpr bool PERM = true, AFTER_DRAIN = false;
    bf16_t *UG, *GV, *Z, *SGB; float* VSTP;
    __device__ __forceinline__ void operator()(const f32x4 (&acc)[2][2][4][2], const Unit& u, int wr, int wc, int fr, int fq) const {
        const int row0 = u.pm * BM + wr * 64 + fr, cl = wc * 32 + 8 * fq;
        if (u.pn < 4) {
            bf16_t* base = UG + (size_t)row0 * 512 + u.pn * 128 + cl;
#pragma unroll
            for (int ai = 0; ai < 2; ++ai)
#pragma unroll
                for (int m = 0; m < 4; ++m) {
                    const f32x4 a0 = acc[ai][0][m][0], a1 = acc[ai][0][m][1], g0 = acc[ai][1][m][0], g1 = acc[ai][1][m][1];
                    const f32x2 p0 = gelu_pk((f32x2){a0[0], a0[1]}), p1 = gelu_pk((f32x2){a0[2], a0[3]}), p2 = gelu_pk((f32x2){a1[0], a1[1]}), p3 = gelu_pk((f32x2){a1[2], a1[3]});
                    u32x4 w;
                    w.x = pk_bf16(p0.x * silu_f(g0[0]), p0.y * silu_f(g0[1])); w.y = pk_bf16(p1.x * silu_f(g0[2]), p1.y * silu_f(g0[3]));
                    w.z = pk_bf16(p2.x * silu_f(g1[0]), p2.y * silu_f(g1[1])); w.w = pk_bf16(p3.x * silu_f(g1[2]), p3.y * silu_f(g1[3]));
                    *(u32x4*)(base + (size_t)(ai * HALF + m * 16) * 512) = w;
                }
        } else if (u.pn < 6) {
            bf16_t* base = GV + (size_t)row0 * 512 + (u.pn - 4) * 256 + cl;
            float* sp = VSTP + (size_t)row0 * 16 + ((u.pn - 4) * 4 + wc) * 2;
#pragma unroll
            for (int ai = 0; ai < 2; ++ai)
#pragma unroll
                for (int m = 0; m < 4; ++m) {
                    float s = 0.f, q = 0.f;
#pragma unroll
                    for (int bj = 0; bj < 2; ++bj) {
                        const f32x4 a0 = acc[ai][bj][m][0], a1 = acc[ai][bj][m][1];
                        const f32x2 p0 = gelu_pk((f32x2){a0[0], a0[1]}), p1 = gelu_pk((f32x2){a0[2], a0[3]}), p2 = gelu_pk((f32x2){a1[0], a1[1]}), p3 = gelu_pk((f32x2){a1[2], a1[3]});
                        s += ((p0.x + p0.y) + (p1.x + p1.y)) + ((p2.x + p2.y) + (p3.x + p3.y));
                        q += ((p0.x * p0.x + p0.y * p0.y) + (p1.x * p1.x + p1.y * p1.y)) + ((p2.x * p2.x + p2.y * p2.y) + (p3.x * p3.x + p3.y * p3.y));
                        u32x4 w; w.x = pk_bf16(p0.x, p0.y); w.y = pk_bf16(p1.x, p1.y); w.z = pk_bf16(p2.x, p2.y); w.w = pk_bf16(p3.x, p3.y);
                        *(u32x4*)(base + (size_t)(ai * HALF + m * 16) * 512 + bj * HALF) = w;
                    }
                    s += __shfl_xor(s, 16); s += __shfl_xor(s, 32); q += __shfl_xor(q, 16); q += __shfl_xor(q, 32);
                    if (fq == 0) *(f32x2*)(sp + (size_t)(ai * HALF + m * 16) * 16) = (f32x2){s, q};
                }
        } else {
            const bool act = u.pn >= 8;
            bf16_t* base = (act ? SGB + (size_t)(u.pn - 8) * 256 : Z + (size_t)(u.pn - 6) * 256) + (size_t)row0 * 512 + cl;
#pragma unroll
            for (int ai = 0; ai < 2; ++ai)
#pragma unroll
                for (int m = 0; m < 4; ++m)
#pragma unroll
                    for (int bj = 0; bj < 2; ++bj) {
                        f32x4 a0 = acc[ai][bj][m][0], a1 = acc[ai][bj][m][1];
                        if (act) { a0 = (f32x4){silu_f(a0[0]), silu_f(a0[1]), silu_f(a0[2]), silu_f(a0[3])}; a1 = (f32x4){silu_f(a1[0]), silu_f(a1[1]), silu_f(a1[2]), silu_f(a1[3])}; }
                        u32x4 w; w.x = pk_bf16(a0[0], a0[1]); w.y = pk_bf16(a0[2], a0[3]); w.z = pk_bf16(a1[0], a1[1]); w.w = pk_bf16(a1[2], a1[3]);
                        *(u32x4*)(base + (size_t)(ai * HALF + m * 16) * 512 + bj * HALF) = w;
                    }
        }
    }
};
struct EpiY {
    static constexpr bool PERM = true, AFTER_DRAIN = false;
    bf16_t* Y; float* YSQ;
    __device__ __forceinline__ void operator()(const f32x4 (&acc)[2][2][4][2], const Unit& u, int wr, int wc, int fr, int fq) const {
        const int row0 = u.pm * BM + wr * 64 + fr, cl = wc * 32 + 8 * fq;
        bf16_t* base = Y + (size_t)row0 * 1024 + u.pn * 256 + cl;
        float* sp = YSQ + (size_t)row0 * 16 + u.pn * 4 + wc;
#pragma unroll
        for (int ai = 0; ai < 2; ++ai)
#pragma unroll
            for (int m = 0; m < 4; ++m) {
                float q = 0.f;
#pragma unroll
                for (int bj = 0; bj < 2; ++bj) {
                    const f32x4 a0 = acc[ai][bj][m][0], a1 = acc[ai][bj][m][1];
                    q += ((a0[0] * a0[0] + a0[1] * a0[1]) + (a0[2] * a0[2] + a0[3] * a0[3])) + ((a1[0] * a1[0] + a1[1] * a1[1]) + (a1[2] * a1[2] + a1[3] * a1[3]));
                    u32x4 w; w.x = pk_bf16(a0[0], a0[1]); w.y = pk_bf16(a0[2], a0[3]); w.z = pk_bf16(a1[0], a1[1]); w.w = pk_bf16(a1[2], a1[3]);
                    *(u32x4*)(base + (size_t)(ai * HALF + m * 16) * 1024 + bj * HALF) = w;
                }
                q += __shfl_xor(q, 16); q += __shfl_xor(q, 32);
                if (fq == 0) sp[(size_t)(ai * HALF + m * 16) * 16] = q;
            }
    }
};
struct PanelOrder {
    int G, c, nM, nN;
    __device__ __forceinline__ bool next(int i, Unit& u) const { const int pm = c + G * (i / nN); if (pm >= nM) return false; u.pm = pm; u.pn = i % nN; return true; }
    __device__ __forceinline__ void a_ready(const Unit&) const {}
    __device__ __forceinline__ void done(const Unit&) const {}
};


template <class Epi, class Sched, bool ALIGN_EPI = false, bool SP2 = false>
__device__ __forceinline__ void gemm_phase(PG8_LAS unsigned char* lds, const Gemm g, const Sched& S, const Epi& E) {
    const int tid = threadIdx.x, wid = __builtin_amdgcn_readfirstlane(tid >> 6), lane = tid & 63, wr = wid >> 2, wc = wid & 3, fr = lane & 15, fq = lane >> 4;
    const int K = g.K, nt = K / BK;
    unsigned voffA[2], voffB[2];
#pragma unroll
    for (int i = 0; i < 2; ++i) { int R, C; stage_rc(tid * 16 + i * 8192, R, C); const int Rb = Epi::PERM ? ((R & ~31) + perm32(R & 31)) : R;
        voffA[i] = (unsigned)(R * K + C) * 2u; voffB[i] = (unsigned)(Rb * K + C) * 2u; }
    const size_t kstep = (size_t)(BK * 2);
    const size_t hstep = (size_t)HALF * K * 2;
    const size_t tstep = 2 * hstep;
    const unsigned ldsw = (unsigned)wid * 1024u;
    const int aoff = lds_byte(wr * 64 + fr, fq * 8), boff = lds_byte(wc * 32 + fr, fq * 8);
#define PG8_SA(b, h) (((b) * 2 + (h)) * HTB)
#define PG8_SB(b, h) ((4 + (b) * 2 + (h)) * HTB)
#define PG8_STAGE(bufoff, gbase, voff) do { _Pragma("unroll") for (int _i = 0; _i < 2; ++_i) \
        __builtin_amdgcn_global_load_lds((const unsigned*)((const char*)(gbase) + (voff)[_i]), (PG8_LAS unsigned*)(lds + (bufoff) + ldsw + _i * 8192), 16, 0, 0); } while (0)
#define PG8_LDA(dst, b, h) do { _Pragma("unroll") for (int m = 0; m < 4; ++m) _Pragma("unroll") for (int k = 0; k < 2; ++k) dst[m][k] = *(const PG8_LAS bf16x8*)(lds + PG8_SA(b, h) + aoff + m * 2048 + k * 1024); } while (0)
#define PG8_LDB(dst, b, h) do { _Pragma("unroll") for (int n = 0; n < 2; ++n) _Pragma("unroll") for (int k = 0; k < 2; ++k) dst[n][k] = *(const PG8_LAS bf16x8*)(lds + PG8_SB(b, h) + boff + n * 2048 + k * 1024); } while (0)
#define PG8_MMA(ai, bj, At, Bt) do { __builtin_amdgcn_s_setprio(1); _Pragma("unroll") for (int m = 0; m < 4; ++m) _Pragma("unroll") for (int n = 0; n < 2; ++n) _Pragma("unroll") for (int k = 0; k < 2; ++k) \
        acc[ai][bj][m][n] = __builtin_amdgcn_mfma_f32_16x16x32_bf16(Bt[n][k], At[m][k], acc[ai][bj][m][n], 0, 0, 0); __builtin_amdgcn_s_setprio(0); } while (0)
#define PG8_WAIT_V(n) asm volatile("s_waitcnt vmcnt(" #n ")" ::: "memory")
#define PG8_WAIT_L(n) asm volatile("s_waitcnt lgkmcnt(" #n ")" ::: "memory")
#define PG8_BAR __builtin_amdgcn_s_barrier()
#define PG8_SCHED __builtin_amdgcn_sched_barrier(0)
    Unit cur, nxt; int ui = 0;
    if (!S.next(0, cur)) return;
    f32x4 acc[2][2][4][2];
#pragma unroll
    for (int a = 0; a < 2; ++a)
#pragma unroll
        for (int b = 0; b < 2; ++b)
#pragma unroll
            for (int m = 0; m < 4; ++m)
#pragma unroll
                for (int n = 0; n < 2; ++n) acc[a][b][m][n] = (f32x4){0.f, 0.f, 0.f, 0.f};
    bf16x8 At[4][2], B0[2][2], B1[2][2];
    const char* cA = (const char*)g.A + (size_t)cur.pm * tstep; const char* cB = (const char*)g.Bt + (size_t)cur.pn * tstep;
    S.a_ready(cur);
    if constexpr (SP2) {
        PG8_STAGE(PG8_SB(0, 0), cB, voffB); PG8_STAGE(PG8_SB(0, 1), cB + hstep, voffB); PG8_STAGE(PG8_SA(0, 0), cA, voffA); PG8_STAGE(PG8_SA(0, 1), cA + hstep, voffA);
        if (wr == 1) PG8_BAR;
        PG8_WAIT_V(2); PG8_BAR;
        PG8_STAGE(PG8_SB(1, 0), cB + kstep, voffB); PG8_STAGE(PG8_SA(1, 0), cA + kstep, voffA); PG8_STAGE(PG8_SB(1, 1), cB + hstep + kstep, voffB);
        PG8_WAIT_V(6); PG8_BAR;
    } else {
        PG8_STAGE(PG8_SB(0, 0), cB, voffB); PG8_STAGE(PG8_SA(0, 0), cA, voffA); PG8_STAGE(PG8_SB(0, 1), cB + hstep, voffB); PG8_STAGE(PG8_SA(0, 1), cA + hstep, voffA);
        if (wr == 1) PG8_BAR;
        PG8_WAIT_V(4); PG8_BAR;
        PG8_STAGE(PG8_SB(1, 0), cB + kstep, voffB); PG8_STAGE(PG8_SA(1, 0), cA + kstep, voffA); PG8_STAGE(PG8_SB(1, 1), cB + hstep + kstep, voffB);
        PG8_WAIT_V(6); PG8_BAR;
    }
    for (;;) {
        const bool has_next = S.next(ui + 1, nxt);
        const char* nA = has_next ? (const char*)g.A + (size_t)nxt.pm * tstep : cA; const char* nB = has_next ? (const char*)g.Bt + (size_t)nxt.pn * tstep : cB;
        for (int t = 0; t < nt; t += 2) {
            const bool last = (t == nt - 2);
            const char* a1 = cA + (size_t)(t + 1) * kstep;
            const char* a2 = last ? nA : cA + (size_t)(t + 2) * kstep; const char* b2 = last ? nB : cB + (size_t)(t + 2) * kstep;
            const char* a3 = a2 + kstep; const char* b3 = b2 + kstep;
            if (last && has_next) S.a_ready(nxt);
            if constexpr (SP2) {
            PG8_LDB(B0, 0, 0); PG8_LDB(B1, 0, 1); PG8_SCHED; PG8_LDA(At, 0, 0); PG8_STAGE(PG8_SA(1, 1), a1 + hstep, voffA);
            PG8_WAIT_V(8); PG8_WAIT_L(0); PG8_BAR; PG8_MMA(0, 0, At, B0); PG8_MMA(0, 1, At, B1); PG8_BAR; PG8_SCHED;
            PG8_LDA(At, 0, 1); PG8_STAGE(PG8_SB(0, 0), b2, voffB); PG8_STAGE(PG8_SB(0, 1), b2 + hstep, voffB); PG8_STAGE(PG8_SA(0, 0), a2, voffA);
            PG8_WAIT_V(8); PG8_WAIT_L(0); PG8_BAR; PG8_MMA(1, 0, At, B0); PG8_MMA(1, 1, At, B1); PG8_BAR; PG8_SCHED;
            PG8_LDB(B0, 1, 0); PG8_LDB(B1, 1, 1); PG8_SCHED; PG8_LDA(At, 1, 0); PG8_STAGE(PG8_SA(0, 1), a2 + hstep, voffA);
            PG8_WAIT_V(8); PG8_WAIT_L(0); PG8_BAR; PG8_MMA(0, 0, At, B0); PG8_MMA(0, 1, At, B1); PG8_BAR; PG8_SCHED;
            PG8_LDA(At, 1, 1); PG8_STAGE(PG8_SB(1, 0), b3, voffB); PG8_STAGE(PG8_SB(1, 1), b3 + hstep, voffB); PG8_STAGE(PG8_SA(1, 0), a3, voffA);
            PG8_WAIT_V(8); PG8_WAIT_L(0); PG8_BAR; PG8_MMA(1, 0, At, B0); PG8_MMA(1, 1, At, B1); PG8_BAR; PG8_SCHED;
            } else {
            PG8_LDB(B0, 0, 0); PG8_SCHED; PG8_LDA(At, 0, 0); PG8_STAGE(PG8_SA(1, 1), a1 + hstep, voffA);
            PG8_WAIT_L(8); PG8_BAR; PG8_WAIT_L(0); PG8_MMA(0, 0, At, B0); PG8_BAR; PG8_SCHED;
            PG8_LDB(B1, 0, 1); PG8_STAGE(PG8_SB(0, 0), b2, voffB);
            PG8_BAR; PG8_WAIT_L(0); PG8_MMA(0, 1, At, B1); PG8_BAR;
            PG8_LDA(At, 0, 1); PG8_STAGE(PG8_SA(0, 0), a2, voffA);
            PG8_BAR; PG8_WAIT_L(0); PG8_MMA(1, 0, At, B0); PG8_BAR; PG8_SCHED;
            PG8_STAGE(PG8_SB(0, 1), b2 + hstep, voffB);
            PG8_WAIT_V(6); PG8_BAR; PG8_MMA(1, 1, At, B1); PG8_BAR;
            PG8_LDB(B0, 1, 0); PG8_SCHED; PG8_LDA(At, 1, 0); PG8_STAGE(PG8_SA(0, 1), a2 + hstep, voffA);
            PG8_WAIT_L(8); PG8_BAR; PG8_WAIT_L(0); PG8_MMA(0, 0, At, B0); PG8_BAR; PG8_SCHED;
            PG8_LDB(B1, 1, 1); PG8_STAGE(PG8_SB(1, 0), b3, voffB);
            PG8_BAR; PG8_WAIT_L(0); PG8_MMA(0, 1, At, B1); PG8_BAR;
            PG8_LDA(At, 1, 1); PG8_STAGE(PG8_SA(1, 0), a3, voffA);
            PG8_BAR; PG8_WAIT_L(0); PG8_MMA(1, 0, At, B0); PG8_BAR; PG8_SCHED;
            PG8_STAGE(PG8_SB(1, 1), b3 + hstep, voffB);
            PG8_WAIT_V(6); PG8_BAR; PG8_MMA(1, 1, At, B1); PG8_BAR;
            }
        }
        if constexpr (ALIGN_EPI) { if (wr == 0) PG8_BAR; }
        if constexpr (!Epi::AFTER_DRAIN) { E(acc, cur, wr, wc, fr, fq); S.done(cur); }
        if (!has_next) break;
#pragma unroll
        for (int a = 0; a < 2; ++a)
#pragma unroll
            for (int b = 0; b < 2; ++b)
#pragma unroll
                for (int m = 0; m < 4; ++m)
#pragma unroll
                    for (int n = 0; n < 2; ++n) acc[a][b][m][n] = (f32x4){0.f, 0.f, 0.f, 0.f};
        cur = nxt; cA = nA; cB = nB; ++ui;
        if constexpr (ALIGN_EPI) { if (wr == 1) PG8_BAR; }
    }
    PG8_WAIT_V(0);
    if constexpr (!ALIGN_EPI) { if (wr == 0) PG8_BAR; }
    PG8_BAR;
    if constexpr (Epi::AFTER_DRAIN) { E.fused(acc, cur, wr, wc, fr, fq, lds, wid, lane); S.done(cur); }
#undef PG8_SA
#undef PG8_SB
#undef PG8_STAGE
#undef PG8_LDA
#undef PG8_LDB
#undef PG8_MMA
#undef PG8_WAIT_V
#undef PG8_WAIT_L
#undef PG8_BAR
#undef PG8_SCHED
}
}
constexpr int NWAVES = 8;
#ifndef MK_N_LAUNCHES
#define MK_N_LAUNCHES 1
#endif
constexpr int N_LAUNCHES = MK_N_LAUNCHES;
constexpr int PER_PHASE = 5;
#ifndef PROBE_REPEAT
#define PROBE_REPEAT -1
#endif

constexpr int BATCH = 32, SEQ = 2048, D = 1024, DA = 512, DB = 512, DIN = 2560;
constexpr int M = BATCH * SEQ;
constexpr float EPS = 1e-6f;

constexpr size_t MiB = 1u << 20;
constexpr size_t WS_CTL = 0, CTL_ZERO_BYTES = 1 * MiB;
constexpr size_t WS_WIN = 2 * MiB;
constexpr size_t WS_WOUT = 8 * MiB;
constexpr size_t WS_WSB = 10 * MiB;
constexpr size_t WS_MT = 11 * MiB;
constexpr size_t WS_ECS = 12 * MiB;
constexpr size_t WS_MTF = 13 * MiB;
constexpr size_t WS_VSTP = 14 * MiB;
constexpr size_t WS_YSQ = 18 * MiB;
constexpr size_t WS_H = 32 * MiB;
constexpr size_t WS_UG = 160 * MiB;
constexpr size_t WS_GV = 224 * MiB;
constexpr size_t WS_Z = 288 * MiB;
constexpr size_t WS_SGB = 352 * MiB;
constexpr size_t WS_X1 = 416 * MiB;
constexpr size_t WS_A2 = 480 * MiB;
constexpr size_t WS_Y = 608 * MiB;
constexpr size_t WS_END = 736 * MiB;
constexpr int CW_TMO = 0, CW_CODE = 1, CW_BAR = 4096;

constexpr int RING_OFF = 0, RING_BYTES = 131072;
constexpr int LDSCTL_OFF = RING_BYTES, MISC_OFF = LDSCTL_OFF + 320;
constexpr int LDS_BYTES = 147456;
static_assert(MISC_OFF + 128 <= LDS_BYTES, "LDS map");


#define GAS __attribute__((address_space(1)))
#define LAS __attribute__((address_space(3)))
typedef unsigned short bf16;
typedef unsigned v4u __attribute__((ext_vector_type(4)));
typedef float f32x4 __attribute__((ext_vector_type(4)));
typedef short bf16x8 __attribute__((ext_vector_type(8)));
typedef GAS unsigned gu32;
typedef GAS unsigned long long gu64;
#define RLX_AGENT __ATOMIC_RELAXED, __HIP_MEMORY_SCOPE_AGENT
#define LDS_WAIT() asm volatile("s_waitcnt lgkmcnt(0)" ::: "memory")
#define VM_WAIT() asm volatile("s_waitcnt vmcnt(0)" ::: "memory")
__device__ __forceinline__ unsigned long long rt() { return __builtin_amdgcn_s_memrealtime(); }
__device__ __forceinline__ unsigned f2bf(float f) { unsigned u = __builtin_bit_cast(unsigned, f); return (u + 0x7fffu + ((u >> 16) & 1u)) >> 16; }
__device__ __forceinline__ unsigned pk2(float lo, float hi) { return f2bf(lo) | (f2bf(hi) << 16); }
#define XB_TMO      128
#define XB_XCNT(j)  (256  + 64 * (j))
#define XB_XSUB(j)  (1280 + 64 * (j))
#define XB_XGEN(j)  (2304 + 64 * (j))
#define XB_TOP      3328
#define XB_TOPGEN   3392
#define XCD_BAR_WORDS 3456
#define XB_SPIN_CAP (1u << 18)

__device__ __forceinline__ unsigned xb_ld(unsigned* p)              { return __hip_atomic_load(p, __ATOMIC_RELAXED, __HIP_MEMORY_SCOPE_AGENT); }
__device__ __forceinline__ unsigned xb_add(unsigned* p, unsigned v) { return __hip_atomic_fetch_add(p, v, __ATOMIC_RELAXED, __HIP_MEMORY_SCOPE_AGENT); }
__device__ __forceinline__ unsigned xb_xcc_id() { return (unsigned)__builtin_amdgcn_s_getreg((3 << 11) | 20) & 0xFu; }
#define XB_SPIN(cond, bar) do { unsigned _sp = 0; while (cond) { __builtin_amdgcn_s_sleep(1); \
    if ((++_sp & 255u) == 0u) { if (xb_ld(&(bar)[XB_TMO])) break; if (_sp > XB_SPIN_CAP) { atomicAdd(&(bar)[XB_TMO], 1u); break; } } } } while (0)

struct XcdBarrier {
    unsigned* bar; unsigned x;
    volatile LAS unsigned* st;
};

__device__ __forceinline__ XcdBarrier xcd_barrier_post(unsigned* bar, volatile LAS unsigned* st) {
    XcdBarrier b; b.bar = bar; b.x = xb_xcc_id(); b.st = st;
    if (threadIdx.x == 0) (void)xb_add(&bar[XB_XCNT(b.x)], 1u);
    return b;
}
__device__ __forceinline__ void xcd_barrier_complete(unsigned* bar, unsigned x, unsigned& nloc, unsigned& nx) {
    const unsigned G = gridDim.x * gridDim.y * gridDim.z;
    unsigned sum, cnt, mine, sp = 0u;
    for (;;) {
        sum = 0u; cnt = 0u; mine = 0u;
#pragma unroll
        for (unsigned j = 0; j < 16; ++j) { const unsigned c = xb_ld(&bar[XB_XCNT(j)]); sum += c; cnt += (c > 0u) ? 1u : 0u; mine = (j == x) ? c : mine; }
        if (sum == G) break;
        __builtin_amdgcn_s_sleep(1);
        if ((++sp & 255u) == 0u) { if (xb_ld(&bar[XB_TMO])) break; if (sp > XB_SPIN_CAP) { atomicAdd(&bar[XB_TMO], 1u); break; } }
    }
    nloc = mine > 0u ? mine : 1u; nx = cnt > 0u ? cnt : 1u;
}

__device__ __forceinline__ void xcd_barrier(const XcdBarrier& b) {
    asm volatile("s_waitcnt vmcnt(0)" ::: "memory");
    __syncthreads();
    if (threadIdx.x == 0) {
        unsigned* bar = b.bar;
        __builtin_amdgcn_s_waitcnt(0);
        unsigned nloc = b.st[0], nx = b.st[1];
        if (nloc == 0u) { xcd_barrier_complete(bar, b.x, nloc, nx); b.st[0] = nloc; b.st[1] = nx; }
        const unsigned old = xb_add(&bar[XB_XSUB(b.x)], 1u);
        const unsigned gen = old / nloc;
        if (old + 1u == (gen + 1u) * nloc) {
            __builtin_amdgcn_fence(__ATOMIC_RELEASE, "agent");
            asm volatile("s_waitcnt vmcnt(0)" ::: "memory");
            const unsigned og = xb_add(&bar[XB_TOP], 1u);
            const unsigned tg = og / nx;
            if (og + 1u == (tg + 1u) * nx) xb_add(&bar[XB_TOPGEN], 1u);
            else XB_SPIN(xb_ld(&bar[XB_TOPGEN]) == tg, bar);
            __builtin_amdgcn_fence(__ATOMIC_ACQUIRE, "agent");
            xb_add(&bar[XB_XGEN(b.x)], 1u);
            asm volatile("s_waitcnt vmcnt(0)" ::: "memory");
        } else {
            XB_SPIN(xb_ld(&bar[XB_XGEN(b.x)]) == gen, bar);
            __builtin_amdgcn_fence(__ATOMIC_ACQUIRE, "agent");
            asm volatile("s_waitcnt vmcnt(0)" ::: "memory");
        }
    }
    __syncthreads();
}
typedef float f32x2 __attribute__((ext_vector_type(2)));
typedef float f32x16 __attribute__((ext_vector_type(16)));
typedef unsigned u32x2 __attribute__((ext_vector_type(2)));
using pg8::pk_bf16;
struct Frame {
    LAS unsigned char* lds;
    volatile LAS unsigned* MISC;
    gu32* ctl;
    int tid, lane, wave;
    int vcu, G;
    const float *x, *pre_g, *post_g, *w_in, *ln_g, *ln_b, *w_s, *b_s, *w_f, *b_f, *w_out; float* out;
    bf16 *WIN, *WOUT, *WSB, *MT, *MTF, *ECS, *H, *UG, *GV, *Z, *SGB, *X1, *A2, *Y;
    float *VSTP, *YSQ;
};
__device__ __forceinline__ float bflo(unsigned w) { return __builtin_bit_cast(float, w << 16); }
__device__ __forceinline__ float bfhi(unsigned w) { return __builtin_bit_cast(float, w & 0xffff0000u); }
__device__ __forceinline__ float wave_sum(float v) {
#pragma unroll
    for (int o = 1; o < 64; o <<= 1) v += __shfl_xor(v, o);
    return v;
}
__device__ __forceinline__ int win_src_col(int n) { const int t = n >> 8, r = n & 255; return t < 4 ? (r < 128 ? t * 128 + r : 1024 + t * 128 + (r - 128)) : (t < 6 ? 512 + (t - 4) * 256 + r : (t < 8 ? 1536 + (t - 6) * 256 + r : 2048 + (t - 8) * 256 + r)); }
__device__ __forceinline__ void p0_transpose_item(const float* W, int K, int N, bf16* WT, const float* kscale, bool remap, LAS float* scr, int item, int lane) {
    const int nblk = N / 32, kb = item / nblk, nb = item % nblk, k0 = 64 * kb, n0 = 32 * nb, s0 = remap ? win_src_col(n0) : n0;
#pragma unroll 8
    for (int i = 0; i < 32; ++i) { const int kk = 2 * i + (lane >> 5); float v = W[(size_t)(k0 + kk) * N + s0 + (lane & 31)]; if (kscale) v *= kscale[k0 + kk]; scr[kk * 33 + (lane & 31)] = v; }
    LDS_WAIT(); asm volatile("" ::: "memory");
    const int c = lane & 7;
#pragma unroll
    for (int j = 0; j < 4; ++j) { const int n = (lane >> 3) + 8 * j; const LAS float* s = scr + (8 * c) * 33 + n;
        v4u o; o.x = pk_bf16(s[0 * 33], s[1 * 33]); o.y = pk_bf16(s[2 * 33], s[3 * 33]); o.z = pk_bf16(s[4 * 33], s[5 * 33]); o.w = pk_bf16(s[6 * 33], s[7 * 33]);
        *(GAS v4u*)(WT + (size_t)(n0 + n) * K + k0 + 8 * c) = o; }
    LDS_WAIT(); asm volatile("" ::: "memory");
}
__device__ __forceinline__ void rms_rows4_to_bf16(Frame& F, const float* xrow, bf16* orow) {
    f32x4 v[4][4]; float s[4];
#pragma unroll
    for (int i = 0; i < 4; ++i) { const GAS f32x4* xr = (const GAS f32x4*)(xrow + (size_t)i * D) + F.lane;
#pragma unroll
        for (int j = 0; j < 4; ++j) v[i][j] = xr[64 * j]; }
#pragma unroll
    for (int i = 0; i < 4; ++i) { s[i] = 0.f;
#pragma unroll
        for (int j = 0; j < 4; ++j) s[i] += (v[i][j].x * v[i][j].x + v[i][j].y * v[i][j].y) + (v[i][j].z * v[i][j].z + v[i][j].w * v[i][j].w); }
#pragma unroll
    for (int o = 1; o < 64; o <<= 1) {
#pragma unroll
        for (int i = 0; i < 4; ++i) s[i] += __shfl_xor(s[i], o); }
#pragma unroll
    for (int i = 0; i < 4; ++i) { const float r = rsqrtf(s[i] * (1.f / D) + EPS); GAS u32x2* o8 = (GAS u32x2*)(orow + (size_t)i * D) + F.lane;
#pragma unroll
        for (int j = 0; j < 4; ++j) o8[64 * j] = (u32x2){pk_bf16(v[i][j].x * r, v[i][j].y * r), pk_bf16(v[i][j].z * r, v[i][j].w * r)}; }
}
__device__ __forceinline__ void p0_prologue(Frame& F) {
    LAS float* scr = (LAS float*)(F.lds + RING_OFF + F.wave * 16384);
    const int gw = F.vcu * NWAVES + F.wave, NGW = F.G * NWAVES;
    constexpr int I_IN = (D / 64) * (DIN / 32), I_OUT = (D / 64) * (D / 32);
    for (int it = gw; it < I_IN + I_OUT; it += NGW) {
        if (it < I_IN) p0_transpose_item(F.w_in, D, DIN, F.WIN, F.pre_g, true, scr, it, F.lane);
        else p0_transpose_item(F.w_out, D, D, F.WOUT, nullptr, false, scr, it - I_IN, F.lane);
    }
    const int gt = gw * 64 + F.lane, NT = NGW * 64;
    for (int i = gt; i < 4 * 128 * 128 / 2; i += NT) { const f32x2 v = *(const f32x2*)(F.w_s + 2 * i); ((unsigned*)F.WSB)[i] = pk_bf16(v.x, v.y); }
    for (int i = gt; i < 16 * 4 * 16 * 64; i += NT) {
        const int ln = i & 63, scs = (i >> 6) & 15, kt = (i >> 10) & 3, k1 = i >> 12, k2 = 32 * kt + (ln & 31), h = ln >> 5, st = scs >> 2, c = (scs >> 1) & 1, s = scs & 1;
        float v[8];
#pragma unroll
        for (int j = 0; j < 8; ++j) { const int sl = 32 * st + 16 * s + 8 * (j >> 2) + 4 * h + (j & 3); const int idx = ((k1 + 16 * k2) * sl) & 2047; float sn, cs; sincospif((float)idx * (1.0f / 1024.0f), &sn, &cs); v[j] = c ? sn : cs; }
        v4u o; o.x = pk_bf16(v[0], v[1]); o.y = pk_bf16(v[2], v[3]); o.z = pk_bf16(v[4], v[5]); o.w = pk_bf16(v[6], v[7]);
        *(v4u*)(F.ECS + (size_t)i * 8) = o;
    }
    {   LAS float* ctab = (LAS float*)(F.lds + RING_OFF + F.wave * 16384 + 12288);
        { float sn, cs; sincospif((float)F.lane * (1.0f / 64.0f), &sn, &cs); ctab[F.lane] = cs; ctab[64 + F.lane] = -cs; }
        LDS_WAIT(); asm volatile("" ::: "memory");
        for (int i = gt; i < 4 * 128 * 128; i += NT) {
            const int c = i & 127, e = (i >> 7) & 127, g = i >> 14; float wc = 0.f, ws = 0.f; const float* wf = F.w_f + (size_t)g * 16384 + e;
#pragma unroll 8
            for (int m = 0; m < 128; ++m) { const int ph = (c * m) & 127; const float w = wf[(size_t)m * 128]; wc += ctab[ph] * w; ws += ctab[(ph + 96) & 127] * w; }
            wc *= (1.0f / 512.0f); ws *= (1.0f / 512.0f);
            unsigned short* mt = (unsigned short*)F.MT + (size_t)g * 65536;
            const unsigned pc = pk_bf16(wc, -ws);
            mt[(size_t)e * 256 + c] = (unsigned short)pc; mt[(size_t)e * 256 + 128 + c] = (unsigned short)(pk_bf16(ws, 0.f));
            mt[(size_t)(128 + e) * 256 + c] = (unsigned short)(pc >> 16); mt[(size_t)(128 + e) * 256 + 128 + c] = (unsigned short)pc;
        }
        LDS_WAIT(); asm volatile("" ::: "memory");
    }
    for (int m = 4 * gw; m < M; m += 4 * NGW) rms_rows4_to_bf16(F, F.x + (size_t)m * D, F.H + (size_t)m * D);
}

__device__ __forceinline__ int lnt_key(int c) { return ((c ^ (c >> 5)) & 1) | (((c >> 3) & 3) << 1) | (((c >> 1) & 1) << 3); }
__device__ __forceinline__ int lnt_off(int c, int qchunk) { return c * 256 + ((qchunk ^ lnt_key(c)) << 4); }
__device__ __forceinline__ void p2_spatial_all(Frame& F) {
    const int tid = F.tid, lane = F.lane, w = F.wave;
    LAS float* st_mu = (LAS float*)(F.lds + 65536);
    LAS float* st_rs = st_mu + 256;
    const int nch = ((int)blockIdx.x + F.G < 512) ? 2 : (((int)blockIdx.x < 512) ? 1 : 0);
    if (nch == 0) return;
    if (tid < 128 * nch) {
        const int cc = tid >> 7, q = tid & 127; const float* sp = F.VSTP + (size_t)(((int)blockIdx.x + cc * F.G) * 128 + q) * 16; float sm = 0.f, qq = 0.f;
#pragma unroll
        for (int i = 0; i < 8; ++i) { sm += sp[2 * i]; qq += sp[2 * i + 1]; }
        const float mu = sm * (1.f / DA), var = fmaxf(qq * (1.f / DA) - mu * mu, 0.f);
        st_mu[tid] = mu; st_rs[tid] = rsqrtf(var + EPS);
    }
    const int cg = lane & 15, tq = lane >> 4, q0 = 16 * w + 4 * tq;
    const int fr = lane & 15, fq = lane >> 4, wcb = (w & 3) * 32, ph = (w >> 2) * 64;
    const int nit = 4 * nch;
    v4u raw[4], ug[4]; bf16x8 wsf[4][4];
#define SP_M0(n) ((((int)blockIdx.x) + ((n) % nch) * F.G) * 128)
#define SP_LDRAW(n) do { const int h_ = (n) / nch, m0_ = SP_M0(n); _Pragma("unroll") for (int i = 0; i < 4; ++i) raw[i] = *(const v4u*)(F.GV + (size_t)(m0_ + q0 + i) * 512 + h_ * 128 + 8 * cg); } while (0)
    SP_LDRAW(0);
    __syncthreads();
#pragma unroll 1
    for (int n = 0; n < nit; ++n) {
        const int h = n / nch, cc = n % nch, m0 = SP_M0(n);
        LAS unsigned char* lnt = F.lds + (n & 1) * 32768;
        {
            float mu4[4], rs4[4];
#pragma unroll
            for (int i = 0; i < 4; ++i) { mu4[i] = st_mu[cc * 128 + q0 + i]; rs4[i] = st_rs[cc * 128 + q0 + i]; }
            const f32x4 g0 = *(const f32x4*)(F.ln_g + h * 128 + 8 * cg), g1 = *(const f32x4*)(F.ln_g + h * 128 + 8 * cg + 4);
            const f32x4 b0 = *(const f32x4*)(F.ln_b + h * 128 + 8 * cg), b1 = *(const f32x4*)(F.ln_b + h * 128 + 8 * cg + 4);
#pragma unroll
            for (int j = 0; j < 8; ++j) {
                const float gg = j < 4 ? g0[j & 3] : g1[j & 3], bb = j < 4 ? b0[j & 3] : b1[j & 3];
                float v[4];
#pragma unroll
                for (int i = 0; i < 4; ++i) { const unsigned wd = raw[i][j >> 1]; const float xv = (j & 1) ? bfhi(wd) : bflo(wd); v[i] = (xv - mu4[i]) * rs4[i] * gg + bb; }
                const int c = 8 * cg + j;
                *(LAS u32x2*)(lnt + lnt_off(c, q0 >> 3) + (q0 & 7) * 2) = (u32x2){pk_bf16(v[0], v[1]), pk_bf16(v[2], v[3])};
            }
        }
        if (n + 1 < nit) SP_LDRAW(n + 1);
#pragma unroll
        for (int t = 0; t < 4; ++t) ug[t] = *(const v4u*)(F.UG + (size_t)(m0 + ph + 16 * t + fr) * 512 + h * 128 + wcb + 8 * fq);
        if (cc == 0) {
#pragma unroll
            for (int t = 0; t < 4; ++t)
#pragma unroll
                for (int ks = 0; ks < 4; ++ks) wsf[t][ks] = *(const bf16x8*)(F.WSB + (size_t)(h * 128 + ph + 16 * t + fr) * 128 + 32 * ks + 8 * fq);
        }
        __syncthreads();
        f32x4 acc[2][4];
#pragma unroll
        for (int nn = 0; nn < 2; ++nn)
#pragma unroll
            for (int t = 0; t < 4; ++t) acc[nn][t] = (f32x4){0.f, 0.f, 0.f, 0.f};
#pragma unroll
        for (int ks = 0; ks < 4; ++ks) {
            bf16x8 a[2];
#pragma unroll
            for (int nn = 0; nn < 2; ++nn) { const int c = wcb + 8 * (fr >> 2) + 4 * nn + (fr & 3); a[nn] = *(const LAS bf16x8*)(lnt + lnt_off(c, 4 * ks + fq)); }
#pragma unroll
            for (int t = 0; t < 4; ++t)
#pragma unroll
                for (int nn = 0; nn < 2; ++nn) acc[nn][t] = __builtin_amdgcn_mfma_f32_16x16x32_bf16(a[nn], wsf[t][ks], acc[nn][t], 0, 0, 0);
        }
#pragma unroll
        for (int t = 0; t < 4; ++t) {
            const int p = ph + 16 * t + fr; const float bs = F.b_s[h * 128 + p]; const v4u u4 = ug[t];
            v4u o;
            o.x = pk_bf16((acc[0][t][0] + bs) * bflo(u4.x), (acc[0][t][1] + bs) * bfhi(u4.x)); o.y = pk_bf16((acc[0][t][2] + bs) * bflo(u4.y), (acc[0][t][3] + bs) * bfhi(u4.y));
            o.z = pk_bf16((acc[1][t][0] + bs) * bflo(u4.z), (acc[1][t][1] + bs) * bfhi(u4.z)); o.w = pk_bf16((acc[1][t][2] + bs) * bflo(u4.w), (acc[1][t][3] + bs) * bfhi(u4.w));
            *(v4u*)(F.A2 + (size_t)(m0 + p) * 1024 + h * 128 + wcb + 8 * fq) = o;
        }
    }
#undef SP_M0
#undef SP_LDRAW
    __syncthreads();
}
__device__ __forceinline__ void dft16(const float (&z)[16], float (&r)[16]) {
    constexpr float C16[16] = {1.f, 0.92387953251f, 0.70710678119f, 0.38268343237f, 0.f, -0.38268343237f, -0.70710678119f, -0.92387953251f, -1.f, -0.92387953251f, -0.70710678119f, -0.38268343237f, 0.f, 0.38268343237f, 0.70710678119f, 0.92387953251f};
    float e[8], o[8];
#pragma unroll
    for (int s = 1; s < 8; ++s) { e[s] = z[s] + z[16 - s]; o[s] = z[s] - z[16 - s]; }
#pragma unroll
    for (int k = 0; k <= 8; ++k) { float a = (k & 1) ? z[0] - z[8] : z[0] + z[8];
#pragma unroll
        for (int s = 1; s < 8; ++s) a += C16[(k * s) & 15] * e[s];
        r[k] = a; }
#pragma unroll
    for (int k = 1; k < 8; ++k) { float a = 0.f;
#pragma unroll
        for (int s = 1; s < 8; ++s) a -= C16[(k * s + 12) & 15] * o[s];
        r[8 + k] = a; }
}
__device__ __forceinline__ size_t dft_item_off(const Frame& F, int n, bool out) {
    const int it = ((int)blockIdx.x + n * F.G) * 512 + F.tid, b = it >> 13, s_lo = (it >> 6) & 127;
    return ((size_t)(out ? b * 16 * 128 : b * 2048) + s_lo) * 512 + 8 * (F.tid & 63);
}
__device__ __forceinline__ void dft_load(const Frame& F, int n, v4u (&dst)[16]) { const bf16* zp = F.Z + dft_item_off(F, n, false);
#pragma unroll
    for (int s = 0; s < 16; ++s) dst[s] = *(const v4u*)(zp + (size_t)s * 128 * 512); }
__device__ __forceinline__ void dft_do(const Frame& F, int n, const v4u (&src)[16]) {
    v4u outp[16];
#pragma unroll
    for (int jp = 0; jp < 4; ++jp) { float zl[16], zh[16], rl[16], rh[16];
#pragma unroll
        for (int s = 0; s < 16; ++s) { zl[s] = bflo(src[s][jp]); zh[s] = bfhi(src[s][jp]); }
        dft16(zl, rl); dft16(zh, rh);
#pragma unroll
        for (int pl = 0; pl < 16; ++pl) outp[pl][jp] = pk_bf16(rl[pl], rh[pl]); }
    bf16* xp = F.X1 + dft_item_off(F, n, true);
#pragma unroll
    for (int pl = 0; pl < 16; ++pl) *(v4u*)(xp + (size_t)pl * 128 * 512) = outp[pl];
}
__device__ __forceinline__ void p2_dft16_all(Frame& F) {
    v4u in[16];
#pragma unroll 1
    for (int n = 0; (int)blockIdx.x + n * F.G < 512; ++n) { dft_load(F, n, in); dft_do(F, n, in); }
}
__device__ __forceinline__ v4u pack8(const f32x16& x, int s) { v4u p; p.x = pk_bf16(x[8 * s], x[8 * s + 1]); p.y = pk_bf16(x[8 * s + 2], x[8 * s + 3]); p.z = pk_bf16(x[8 * s + 4], x[8 * s + 5]); p.w = pk_bf16(x[8 * s + 6], x[8 * s + 7]); return p; }
__device__ __forceinline__ void p3_unit_decode(int ui, int& b, int& k1) { b = ui >> 4; const int j = ui & 15; k1 = j < 8 ? j : (j == 8 ? 8 : 24 - j); }
__device__ __forceinline__ void p2_mtf(Frame& F) {
    const int gt = (F.vcu * NWAVES + F.wave) * 64 + F.lane, NT = F.G * NWAVES * 64;
    for (int i2 = gt; i2 < 2 * 32768; i2 += NT) { const int i = i2 & 32767, ln = i & 63, ks = (i >> 6) & 15, et = (i >> 10) & 3, c = (i >> 12) & 1, g = i >> 13;
        v4u t = *(const v4u*)(F.MT + ((size_t)(g * 256 + c * 128 + et * 32 + (ln & 31))) * 256 + 16 * ks + 8 * (ln >> 5));
        const unsigned fl = (i2 >= 32768 && ks >= 8) ? 0x80008000u : 0u; t.x ^= fl; t.y ^= fl; t.z ^= fl; t.w ^= fl;
        *(v4u*)(F.MTF + (size_t)i2 * 8) = t; }
}
__device__ __forceinline__ void p3_slab_dma(Frame& F, LAS unsigned char* slab, int b, int k1, int g) {
    const int k1p = k1 <= 8 ? k1 : 16 - k1; const bool has_im = (k1p != 0 && k1p != 8);
    const bf16* xr = F.X1 + ((size_t)(b * 16 + k1p) * 128) * 512 + g * 128; const bf16* xi = has_im ? F.X1 + ((size_t)(b * 16 + 8 + k1p) * 128) * 512 + g * 128 : xr;
    int ln = F.lane; asm volatile("" : "+v"(ln));
#pragma unroll
    for (int i = 0; i < 8; ++i) { const int pc = i * 8 + F.wave, row = 2 * pc + (ln >> 5), c = (ln & 31) ^ (row & 15);
        const bf16* src = (c >= 16 ? xi : xr) + (size_t)row * 512 + (c & 15) * 8;
        __builtin_amdgcn_global_load_lds((const unsigned*)src, (LAS unsigned*)(slab + pc * 1024), 16, 0, 0); }
}
__device__ __forceinline__ void p3_fourier_all(Frame& F) {
    LAS unsigned char* slab = F.lds; LAS unsigned char* xb = F.lds + 65536;
    const int lane = F.lane, w = F.wave, r = lane & 31, hh = lane >> 5;
    const int et1 = w & 3, c1 = w >> 2;
    const int kt2 = w & 3, eh2 = w >> 2;
    bf16x8 bm[16];
#define P3_LDBM16(gg, cj) do { _Pragma("unroll") for (int q_ = 0; q_ < 16; ++q_) bm[q_] = *(const bf16x8*)(F.MTF + (size_t)(cj) * 262144 + ((((size_t)(gg) * 2 + c1) * 4 + et1) * 16 + q_) * 512 + lane * 8); } while (0)
    bool first = true;
#pragma unroll 1
    for (int ui = blockIdx.x; ui < 512; ui += F.G) {
        int b, k1; p3_unit_decode(ui, b, k1);
        const int k1p = k1 <= 8 ? k1 : 16 - k1; const bool has_im = (k1p != 0 && k1p != 8);
        bf16x8 Ef[16];
#pragma unroll
        for (int scs = 0; scs < 16; ++scs) Ef[scs] = *(const bf16x8*)(F.ECS + ((((size_t)k1 * 4 + kt2) * 16 + scs) * 64 + lane) * 8);
        if (first) { p3_slab_dma(F, slab, b, k1, 0); P3_LDBM16(0, k1 > 8 ? 1 : 0); asm volatile("s_waitcnt vmcnt(0)" ::: "memory"); __syncthreads(); first = false; }
        const int k2 = 32 * kt2 + r;
#pragma unroll 1
        for (int g = 0; g < 4; ++g) {
#pragma unroll
            for (int pass = 0; pass < 2; ++pass) {
                f32x16 Dt[2];
#pragma unroll
                for (int a = 0; a < 2; ++a)
#pragma unroll
                    for (int i = 0; i < 16; ++i) Dt[a][i] = 0.f;
#pragma unroll
                for (int ks = 0; ks < 16; ++ks) {
                    if (ks < 8 || has_im) {
#pragma unroll
                        for (int sti = 0; sti < 2; ++sti) { const int row = 32 * (2 * pass + sti) + r; const bf16x8 ax = *(const LAS bf16x8*)(slab + row * 512 + (((2 * ks + hh) ^ (row & 15)) << 4));
                            Dt[sti] = __builtin_amdgcn_mfma_f32_32x32x16_bf16(ax, bm[ks], Dt[sti], 0, 0, 0); }
                    }
                }
#pragma unroll
                for (int sti = 0; sti < 2; ++sti)
#pragma unroll
                    for (int s = 0; s < 2; ++s) *(LAS v4u*)(xb + (((((2 * pass + sti) * 2 + c1) * 2 + s) * 4 + et1) << 10) + lane * 16) = pack8(Dt[sti], s);
            }
            __syncthreads();
            const bool nxt_unit = (g == 3), has_next = !nxt_unit || (ui + F.G < 512);
            if (has_next) { int nb = b, nk1 = k1; if (nxt_unit) p3_unit_decode(ui + F.G, nb, nk1); p3_slab_dma(F, slab, nb, nk1, nxt_unit ? 0 : g + 1); }
            f32x16 Yt[2];
#pragma unroll
            for (int a = 0; a < 2; ++a)
#pragma unroll
                for (int i = 0; i < 16; ++i) Yt[a][i] = 0.f;
#pragma unroll
            for (int scs = 0; scs < 16; ++scs)
#pragma unroll
                for (int eti = 0; eti < 2; ++eti) { const bf16x8 df = *(const LAS bf16x8*)(xb + ((scs * 4 + 2 * eh2 + eti) << 10) + lane * 16);
                    Yt[eti] = __builtin_amdgcn_mfma_f32_32x32x16_bf16(df, Ef[scs], Yt[eti], 0, 0, 0); }
            int tidl = F.tid; asm volatile("" : "+v"(tidl));
            v4u sgq[4];
#pragma unroll
            for (int i = 0; i < 4; ++i) { const int cidx = i * 512 + tidl, rw = cidx >> 4, ch = cidx & 15; sgq[i] = *(const v4u*)(F.SGB + ((size_t)b * 2048 + k1 + 16 * rw) * 512 + g * 128 + ch * 8); }
            __syncthreads();
#pragma unroll
            for (int eti = 0; eti < 2; ++eti)
#pragma unroll
                for (int qd = 0; qd < 4; ++qd) { const int el = (2 * eh2 + eti) * 32 + 8 * qd + 4 * hh; const f32x4 bias = *(const f32x4*)(F.b_f + g * 128 + el);
                    const u32x2 o = {pk_bf16(Yt[eti][4 * qd + 0] + bias[0], Yt[eti][4 * qd + 1] + bias[1]), pk_bf16(Yt[eti][4 * qd + 2] + bias[2], Yt[eti][4 * qd + 3] + bias[3])};
                    *(LAS u32x2*)(xb + k2 * 256 + ((((el >> 3) ^ (k2 & 15)) << 4) | (hh << 3))) = o; }
            if (has_next) { int nb = b, nk1 = k1; if (nxt_unit) p3_unit_decode(ui + F.G, nb, nk1); P3_LDBM16(nxt_unit ? 0 : g + 1, nk1 > 8 ? 1 : 0); }
            __syncthreads();
#pragma unroll
            for (int i = 0; i < 4; ++i) { const int cidx = i * 512 + tidl, rw = cidx >> 4, ch = cidx & 15;
                const v4u yv = *(const LAS v4u*)(xb + rw * 256 + ((ch ^ (rw & 15)) << 4)); const v4u sv = sgq[i];
                v4u o; o.x = pk_bf16(bflo(yv.x) * bflo(sv.x), bfhi(yv.x) * bfhi(sv.x)); o.y = pk_bf16(bflo(yv.y) * bflo(sv.y), bfhi(yv.y) * bfhi(sv.y));
                o.z = pk_bf16(bflo(yv.z) * bflo(sv.z), bfhi(yv.z) * bfhi(sv.z)); o.w = pk_bf16(bflo(yv.w) * bflo(sv.w), bfhi(yv.w) * bfhi(sv.w));
                *(v4u*)(F.A2 + ((size_t)b * 2048 + k1 + 16 * rw) * 1024 + 512 + g * 128 + ch * 8) = o; }
            asm volatile("s_waitcnt vmcnt(0)" ::: "memory");
            __syncthreads();
        }
    }
#undef P3_LDBM16
}
__device__ __forceinline__ void p5_final_rows(Frame& F, int row0, int nrows) {
    const int lane = F.lane;
    f32x4 pg[4];
#pragma unroll
    for (int j = 0; j < 4; ++j) pg[j] = *(const f32x4*)(F.post_g + 4 * lane + 256 * j);
    for (int mb = row0 + 4 * F.wave; mb < row0 + nrows; mb += 4 * NWAVES) {
        float qv = F.YSQ[(size_t)mb * 16 + lane];
        u32x2 y[4][4]; f32x4 xv[4][4];
#pragma unroll
        for (int i = 0; i < 4; ++i) {
#pragma unroll
            for (int j = 0; j < 4; ++j) { y[i][j] = *(const u32x2*)(F.Y + (size_t)(mb + i) * D + 4 * lane + 256 * j); xv[i][j] = *(const f32x4*)(F.x + (size_t)(mb + i) * D + 4 * lane + 256 * j); } }
        qv += __shfl_xor(qv, 1); qv += __shfl_xor(qv, 2); qv += __shfl_xor(qv, 4); qv += __shfl_xor(qv, 8);
#pragma unroll
        for (int i = 0; i < 4; ++i) {
            const float rstd = rsqrtf(__shfl(qv, 16 * i) * (1.f / D) + EPS);
#pragma unroll
            for (int j = 0; j < 4; ++j) { const unsigned w0 = y[i][j].x, w1 = y[i][j].y;
                f32x4 o; o.x = xv[i][j].x + bflo(w0) * rstd * pg[j].x; o.y = xv[i][j].y + bfhi(w0) * rstd * pg[j].y; o.z = xv[i][j].z + bflo(w1) * rstd * pg[j].z; o.w = xv[i][j].w + bfhi(w1) * rstd * pg[j].w;
                *(f32x4*)(F.out + (size_t)(mb + i) * D + 4 * lane + 256 * j) = o; }
        }
    }
}

struct Args { const float* in[11]; float* out; unsigned char* ws; int ph_lo, ph_hi, li, pad; };
__global__ void __launch_bounds__(NWAVES * 64, 2) mega_fwd(Args args) {
    extern __shared__ __attribute__((aligned(16))) unsigned char lds[];
    Frame F;
    F.lds = (LAS unsigned char*)lds;
    F.MISC = (volatile LAS unsigned*)(F.lds + MISC_OFF);
    F.tid = threadIdx.x; F.lane = F.tid & 63; F.wave = __builtin_amdgcn_readfirstlane(F.tid >> 6);
    F.G = gridDim.x; { const int bx = blockIdx.x; F.vcu = (F.G % 8 == 0) ? (bx % 8) * (F.G / 8) + bx / 8 : bx; }
    unsigned char* ws = args.ws;
    F.ctl = (gu32*)(ws + WS_CTL);
    F.x = args.in[0]; F.pre_g = args.in[1]; F.post_g = args.in[2]; F.w_in = args.in[3]; F.ln_g = args.in[4]; F.ln_b = args.in[5]; F.w_s = args.in[6]; F.b_s = args.in[7];
    F.w_f = args.in[8]; F.b_f = args.in[9]; F.w_out = args.in[10]; F.out = args.out;
    F.WIN = (bf16*)(ws + WS_WIN); F.WOUT = (bf16*)(ws + WS_WOUT); F.WSB = (bf16*)(ws + WS_WSB); F.MT = (bf16*)(ws + WS_MT); F.MTF = (bf16*)(ws + WS_MTF); F.ECS = (bf16*)(ws + WS_ECS);
    F.H = (bf16*)(ws + WS_H); F.UG = (bf16*)(ws + WS_UG); F.GV = (bf16*)(ws + WS_GV); F.Z = (bf16*)(ws + WS_Z); F.SGB = (bf16*)(ws + WS_SGB); F.X1 = (bf16*)(ws + WS_X1);
    F.A2 = (bf16*)(ws + WS_A2); F.Y = (bf16*)(ws + WS_Y); F.VSTP = (float*)(ws + WS_VSTP); F.YSQ = (float*)(ws + WS_YSQ);
    for (int u = F.tid; u < (LDS_BYTES - LDSCTL_OFF) / 4; u += NWAVES * 64) ((LAS unsigned*)(F.lds + LDSCTL_OFF))[u] = 0u;
    __syncthreads();
    XcdBarrier bar; bar.bar = (unsigned*)(F.ctl + CW_BAR); bar.x = 0; bar.st = nullptr;
    if (N_LAUNCHES != PER_PHASE) bar = xcd_barrier_post((unsigned*)(F.ctl + CW_BAR), F.MISC + 8);
#define GRID_BAR() do { if (N_LAUNCHES != PER_PHASE) xcd_barrier(bar); } while (0)
    const int lo = args.ph_lo, hi = args.ph_hi;
#define IN(k) (lo <= (k) && (k) < hi)
#define BOTH(k) (IN(k) && IN((k) + 1))
    if (IN(0)) { p0_prologue(F); if (BOTH(0)) GRID_BAR(); }
    if (IN(1)) {
        pg8::Gemm g{F.H, F.WIN, M, DIN, D}; pg8::StaticOrder S; S.init(M, DIN, F.G, (int)blockIdx.x);
        pg8::EpiIn E{F.UG, F.GV, F.Z, F.SGB, F.VSTP};
        pg8::gemm_phase<pg8::EpiIn, pg8::StaticOrder, true, true>(F.lds + RING_OFF, g, S, E);
        if (BOTH(1)) GRID_BAR();
    }
    if (IN(2)) {
        p2_mtf(F);
        p2_spatial_all(F);
        p2_dft16_all(F);
        if (BOTH(2)) GRID_BAR();
    }
    if (IN(3)) {
        p3_fourier_all(F);
        if (BOTH(3)) GRID_BAR();
    }
    if (IN(4)) {
        pg8::Gemm g{F.A2, F.WOUT, M, D, D}; pg8::PanelOrder S{F.G, F.vcu, M / 256, D / 256};
        pg8::EpiY E{F.Y, F.YSQ};
        pg8::gemm_phase<pg8::EpiY, pg8::PanelOrder, true, true>(F.lds + RING_OFF, g, S, E);
        __builtin_amdgcn_fence(__ATOMIC_ACQUIRE, "agent");
        for (int pm = F.vcu; pm < M / 256; pm += F.G) p5_final_rows(F, pm * 256, 256);
    }
#undef IN
#undef BOTH
}

extern "C" void kernel_launch(void* const* d_in, const int* in_sizes, int n_in, void* d_out, int out_size, void* d_ws, size_t ws_size, hipStream_t stream) {
    static int grid = 0;
    if (grid == 0) {
        if (n_in != 11 || in_sizes[0] != M * D || out_size != M * D || ws_size < WS_END) { fprintf(stderr, "kernel_launch: unexpected shapes / workspace (n_in %d, in0 %d, out %d, ws %zu)\n", n_in, n_in > 0 ? in_sizes[0] : -1, out_size, ws_size); grid = -1; return; }
        int dev = 0, cus = 0, per_cu = 0;
        if (hipGetDevice(&dev) != hipSuccess || hipDeviceGetAttribute(&cus, hipDeviceAttributeMultiprocessorCount, dev) != hipSuccess) { grid = -1; return; }
        if (hipFuncSetAttribute((const void*)mega_fwd, hipFuncAttributeMaxDynamicSharedMemorySize, LDS_BYTES) != hipSuccess) { fprintf(stderr, "kernel_launch: hipFuncSetAttribute failed\n"); grid = -1; return; }
        if (hipOccupancyMaxActiveBlocksPerMultiprocessor(&per_cu, (const void*)mega_fwd, NWAVES * 64, LDS_BYTES) != hipSuccess || per_cu < 1) { fprintf(stderr, "kernel_launch: occupancy query says %d blocks per CU\n", per_cu); (void)hipGetLastError(); per_cu = 1; }
        grid = cus;
    }
    if (grid < 0) return;
    (void)hipMemsetAsync((char*)d_ws + WS_CTL, 0, CTL_ZERO_BYTES, stream);
    Args a; memset(&a, 0, sizeof(a));
    for (int i = 0; i < 11; ++i) a.in[i] = (const float*)d_in[i];
    a.out = (float*)d_out; a.ws = (unsigned char*)d_ws;
    for (int li = 0; li < N_LAUNCHES; ++li) {
        a.ph_lo = (N_LAUNCHES == PER_PHASE) ? li : 0; a.ph_hi = (N_LAUNCHES == PER_PHASE) ? li + 1 : PER_PHASE; a.li = li;
        hipLaunchKernelGGL(mega_fwd, dim3(grid), dim3(NWAVES * 64), LDS_BYTES, stream, a);
    }
    if (PROBE_REPEAT >= 0) { a.ph_lo = PROBE_REPEAT; a.ph_hi = PROBE_REPEAT + 1; a.li = 1; hipLaunchKernelGGL(mega_fwd, dim3(grid), dim3(NWAVES * 64), LDS_BYTES, stream, a); }
}
```
